# Optimizing an MI355X kernel written in HIP

```python
import math
import jax, jax.numpy as jnp
from jax import lax
import numpy as np

D_MODEL = 1024
BATCH = 8
SEQ = 8192
DEPTH = 1
DEC_BATCH = 4
DEC_SEQ = 4096
PAST_LEN = 128

D_S5 = D_MODEL // 2
S5_GROUP = 16
S5_GROUPS = D_S5 // S5_GROUP
S5_STATE = 64
N_DIR = 2
D_CONV = D_MODEL // 2
CONV_WIDTH = 3
N_MEM = 256
XATTN_HEADS = 4
XATTN_HEAD_DIM = D_MODEL // XATTN_HEADS
D_FF = -(-8 * D_MODEL // (3 * 256)) * 256
N_GATES = 2
D_IN = D_S5 + 3 * D_CONV + N_GATES * D_MODEL
EPS = 1e-6
DT_MIN = 1e-3
DT_MAX = 1e-1

kernel_name = "hybrid_s5_shortconv_memxattn_encoder"


def rmsnorm(x, g):
    xf = x.astype(jnp.float32)
    r = lax.rsqrt(jnp.mean(xf * xf, axis=-1, keepdims=True) + EPS)
    return (xf * r * g.astype(jnp.float32)).astype(x.dtype)


def s5_combine(e1, e2):
    a1, b1 = e1
    a2, b2 = e2
    return a1 * a2, a2 * b1 + b2


def s5_direction(u, a_re, a_im, log_dt, b_re, b_im, c_re, c_im, reverse):
    f32 = jnp.float32
    A = lax.complex(a_re.astype(f32), a_im.astype(f32))
    dt = jnp.exp(log_dt.astype(f32))[:, None]
    A_bar = jnp.exp(A * dt)
    Bm = lax.complex(b_re.astype(f32), b_im.astype(f32))
    B_bar = ((A_bar - 1.0) / A)[..., None] * Bm
    Cm = lax.complex(c_re.astype(f32), c_im.astype(f32))
    bu = jnp.einsum("gnp,blgp->blgn", B_bar, u.astype(jnp.complex64))
    a = jnp.broadcast_to(A_bar, bu.shape)
    _, h = lax.associative_scan(s5_combine, (a, bu), reverse=reverse, axis=1)
    return jnp.einsum("gpn,blgn->blgp", Cm, h).real


def hybrid_mixer(xn, w_in, b_gate, s5_a_re, s5_a_im, s5_log_dt, s5_b_re, s5_b_im,
                 s5_c_re, s5_c_im, s5_d, w_glu_a, w_glu_b, conv_w, w_conv_out, w_o):
    f32 = jnp.float32
    bsz, L, _ = xn.shape
    proj = jnp.einsum("bld,de->ble", xn, w_in)
    u_s5, x_c, gate_b, gate_c, g = jnp.split(
        proj, [D_S5, D_S5 + D_CONV, D_S5 + 2 * D_CONV, D_S5 + 3 * D_CONV], axis=-1)
    gates = jax.nn.sigmoid((g + b_gate).astype(f32))

    u = u_s5.astype(f32).reshape(bsz, L, S5_GROUPS, S5_GROUP)
    y = (s5_direction(u, s5_a_re[0], s5_a_im[0], s5_log_dt[0], s5_b_re[0], s5_b_im[0],
                      s5_c_re[0], s5_c_im[0], reverse=False)
         + s5_direction(u, s5_a_re[1], s5_a_im[1], s5_log_dt[1], s5_b_re[1], s5_b_im[1],
                        s5_c_re[1], s5_c_im[1], reverse=True))
    y = y.reshape(bsz, L, D_S5) + s5_d.astype(f32) * u_s5.astype(f32)
    y = jax.nn.gelu(y).astype(xn.dtype)
    s5_out = (y @ w_glu_a) * jax.nn.sigmoid(y @ w_glu_b)

    z = gate_c * x_c
    zp = jnp.pad(z, ((0, 0), (1, 1), (0, 0)))
    zc = conv_w[0] * zp[:, :-2] + conv_w[1] * zp[:, 1:-1] + conv_w[2] * zp[:, 2:]
    conv_out = (gate_b * zc) @ w_conv_out

    merged = gates[..., :D_MODEL] * s5_out.astype(f32) + gates[..., D_MODEL:] * conv_out.astype(f32)
    return merged.astype(xn.dtype) @ w_o


def memory_cross_attention(hn, mem, norm_mem_g, w_q, w_kv, w_xo):
    bsz, L, _ = hn.shape
    mn = rmsnorm(mem, norm_mem_g)
    q = (hn @ w_q).reshape(bsz, L, XATTN_HEADS, XATTN_HEAD_DIM)
    k, v = jnp.split(mn @ w_kv, 2, axis=-1)
    k = k.reshape(bsz, N_MEM, XATTN_HEADS, XATTN_HEAD_DIM)
    v = v.reshape(bsz, N_MEM, XATTN_HEADS, XATTN_HEAD_DIM)
    s = jnp.einsum("blhd,bmhd->bhlm", q, k).astype(jnp.float32) * (XATTN_HEAD_DIM ** -0.5)
    p = jax.nn.softmax(s, axis=-1).astype(v.dtype)
    o = jnp.einsum("bhlm,bmhd->blhd", p, v).reshape(bsz, L, D_MODEL)
    return o @ w_xo


def swiglu(hn, w_gate_up, w_down):
    gate, up = jnp.split(hn @ w_gate_up, 2, axis=-1)
    return (jax.nn.silu(gate) * up) @ w_down


def trunk(x, mem, norm_mix_g, w_in, b_gate, s5_a_re, s5_a_im, s5_log_dt, s5_b_re, s5_b_im,
          s5_c_re, s5_c_im, s5_d, w_glu_a, w_glu_b, conv_w, w_conv_out, w_o,
          norm_xattn_g, norm_mem_g, w_q, w_kv, w_xo, norm_ffn_g, w_gate_up, w_down,
          norm_final_g):
    h = x
    for l in range(DEPTH):
        xn = rmsnorm(h, norm_mix_g[l])
        h = h + hybrid_mixer(xn, w_in[l], b_gate[l], s5_a_re[l], s5_a_im[l], s5_log_dt[l],
                             s5_b_re[l], s5_b_im[l], s5_c_re[l], s5_c_im[l], s5_d[l],
                             w_glu_a[l], w_glu_b[l], conv_w[l], w_conv_out[l], w_o[l])
        hn = rmsnorm(h, norm_xattn_g[l])
        h = h + memory_cross_attention(hn, mem, norm_mem_g[l], w_q[l], w_kv[l], w_xo[l])
        hn = rmsnorm(h, norm_ffn_g[l])
        h = h + swiglu(hn, w_gate_up[l], w_down[l])
    return rmsnorm(h, norm_final_g)


def setup_inputs(seed: int = 0) -> dict:
    key = jax.random.key(seed)
    ks = jax.random.split(key, 32)
    f32 = jnp.float32
    nrm = lambda k, shape, scale: jax.random.normal(k, shape, f32) * scale
    gain = lambda k, shape: 1.0 + 0.02 * jax.random.normal(k, shape, f32)
    sd = (DEPTH, N_DIR, S5_GROUPS, S5_STATE)
    n_idx = jnp.arange(S5_STATE, dtype=f32)
    return {
        "x_prompt": nrm(ks[0], (BATCH, SEQ, D_MODEL), 1.0),
        "x_sample": nrm(ks[1], (DEC_BATCH, DEC_SEQ, D_MODEL), 1.0),
        "mem_prompt": nrm(ks[2], (BATCH, N_MEM, D_MODEL), 1.0),
        "mem_sample": nrm(ks[3], (DEC_BATCH, N_MEM, D_MODEL), 1.0),
        "norm_mix_g": gain(ks[4], (DEPTH, D_MODEL)),
        "w_in": nrm(ks[5], (DEPTH, D_MODEL, D_IN), D_MODEL ** -0.5),
        "b_gate": nrm(ks[6], (DEPTH, N_GATES * D_MODEL), 0.01),
        "s5_a_re": -0.5 + 0.01 * jax.random.normal(ks[7], sd, f32),
        "s5_a_im": math.pi * n_idx + 0.01 * jax.random.normal(ks[8], sd, f32),
        "s5_log_dt": jax.random.uniform(ks[9], (DEPTH, N_DIR, S5_GROUPS), f32,
                                        math.log(DT_MIN), math.log(DT_MAX)),
        "s5_b_re": nrm(ks[10], sd + (S5_GROUP,), (2 * S5_GROUP) ** -0.5),
        "s5_b_im": nrm(ks[11], sd + (S5_GROUP,), (2 * S5_GROUP) ** -0.5),
        "s5_c_re": nrm(ks[12], (DEPTH, N_DIR, S5_GROUPS, S5_GROUP, S5_STATE), (2 * S5_STATE) ** -0.5),
        "s5_c_im": nrm(ks[13], (DEPTH, N_DIR, S5_GROUPS, S5_GROUP, S5_STATE), (2 * S5_STATE) ** -0.5),
        "s5_d": nrm(ks[14], (DEPTH, D_S5), 1.0),
        "w_glu_a": nrm(ks[15], (DEPTH, D_S5, D_MODEL), D_S5 ** -0.5),
        "w_glu_b": nrm(ks[16], (DEPTH, D_S5, D_MODEL), D_S5 ** -0.5),
        "conv_w": nrm(ks[17], (DEPTH, CONV_WIDTH, D_CONV), CONV_WIDTH ** -0.5),
        "w_conv_out": nrm(ks[18], (DEPTH, D_CONV, D_MODEL), D_CONV ** -0.5),
        "w_o": nrm(ks[19], (DEPTH, D_MODEL, D_MODEL), D_MODEL ** -0.5),
        "norm_xattn_g": gain(ks[20], (DEPTH, D_MODEL)),
        "norm_mem_g": gain(ks[21], (DEPTH, D_MODEL)),
        "w_q": nrm(ks[22], (DEPTH, D_MODEL, D_MODEL), D_MODEL ** -0.5),
        "w_kv": nrm(ks[23], (DEPTH, D_MODEL, 2 * D_MODEL), D_MODEL ** -0.5),
        "w_xo": nrm(ks[24], (DEPTH, D_MODEL, D_MODEL), D_MODEL ** -0.5),
        "norm_ffn_g": gain(ks[25], (DEPTH, D_MODEL)),
        "w_gate_up": nrm(ks[26], (DEPTH, D_MODEL, 2 * D_FF), D_MODEL ** -0.5),
        "w_down": nrm(ks[27], (DEPTH, D_FF, D_MODEL), D_FF ** -0.5),
        "norm_final_g": gain(ks[28], (D_MODEL,)),
    }


def reference(x_prompt, x_sample, mem_prompt, mem_sample, norm_mix_g, w_in, b_gate,
              s5_a_re, s5_a_im, s5_log_dt, s5_b_re, s5_b_im, s5_c_re, s5_c_im, s5_d,
              w_glu_a, w_glu_b, conv_w, w_conv_out, w_o, norm_xattn_g, norm_mem_g,
              w_q, w_kv, w_xo, norm_ffn_g, w_gate_up, w_down, norm_final_g):
    weights = (norm_mix_g, w_in, b_gate, s5_a_re, s5_a_im, s5_log_dt, s5_b_re, s5_b_im,
               s5_c_re, s5_c_im, s5_d, w_glu_a, w_glu_b, conv_w, w_conv_out, w_o,
               norm_xattn_g, norm_mem_g, w_q, w_kv, w_xo, norm_ffn_g, w_gate_up, w_down,
               norm_final_g)
    y_prompt = trunk(x_prompt, mem_prompt, *weights)
    y_sample = trunk(x_sample, mem_sample, *weights)
    return (y_prompt, y_sample)
```

```cpp
#include <hip/hip_runtime.h>
#include <hip/hip_cooperative_groups.h>
#include <cstdio>
namespace cg = cooperative_groups;

#ifndef N_LAUNCH_MODE
#define N_LAUNCH_MODE 1
#endif

#define LAS __attribute__((address_space(3)))
typedef unsigned short bf16_t;
typedef short bf16x8 __attribute__((ext_vector_type(8)));
typedef float f32x4 __attribute__((ext_vector_type(4)));
typedef unsigned u32x4 __attribute__((ext_vector_type(4)));
typedef unsigned u32x2 __attribute__((ext_vector_type(2)));

constexpr int D = 1024, M = 81920, MPROMPT = 65536, MEMR = 3072, DFF = 2816;
constexpr int LC = 32, KCAT = 256 + 16 * LC, NG = 32;
constexpr float EPS = 1e-6f;
constexpr int NPHASE = 14;

constexpr size_t MB1 = 1048576;
constexpr size_t W_IN = 0;
constexpr size_t W_GLU = W_IN + 4096ull * 1024 * 2;
constexpr size_t W_CONV = W_GLU + 2048ull * 512 * 2;
constexpr size_t W_O = W_CONV + 1024ull * 512 * 2;
constexpr size_t W_Q = W_O + 1024ull * 1024 * 2;
constexpr size_t W_KV = W_Q + 1024ull * 1024 * 2;
constexpr size_t W_XO = W_KV + 2048ull * 1024 * 2;
constexpr size_t W_GU = W_XO + 1024ull * 1024 * 2;
constexpr size_t W_DN = W_GU + 5632ull * 1024 * 2;
constexpr size_t BT_STATE = W_DN + 1024ull * 2816 * 2;
constexpr size_t BT_Y = BT_STATE + 32ull * 256 * 512 * 2;
constexpr size_t KTAB = BT_Y + 32ull * 512 * 768 * 2;
constexpr size_t MBUF = KTAB + 2ull * 32 * 32 * 256 * 4;
constexpr size_t KK = MBUF + 3072ull * 1024 * 2;
constexpr size_t VT = KK + 3072ull * 1024 * 2;
constexpr size_t RINV0 = VT + 3072ull * 1024 * 2;
constexpr size_t RINVM = RINV0 + (size_t)M * 4;
constexpr size_t SSQ1 = RINVM + 3072ull * 4;
constexpr size_t SSQ2 = SSQ1 + (size_t)M * 64;
constexpr size_t SSQ3 = SSQ2 + (size_t)M * 64;
constexpr size_t LPART = SSQ3 + (size_t)M * 64;
constexpr size_t RINV0P = LPART + (size_t)M * 64;
constexpr size_t RINVMP = RINV0P + (size_t)(M / 2) * 128;
constexpr size_t BARW = RINVMP + (size_t)(MEMR / 2) * 128;
constexpr size_t R0_END = BARW + 16384;
constexpr size_t SLOT = 160 * MB1;
constexpr size_t SLOT_A = 128 * MB1;
constexpr size_t SLOT_B = SLOT_A + SLOT;
constexpr size_t SLOT_C = SLOT_B + SLOT;
constexpr size_t SLOT_D = SLOT_C + SLOT;
constexpr size_t SLOT_E = SLOT_D + SLOT;
constexpr size_t WQN = SLOT_E + SLOT;
constexpr size_t BT_QK = WQN + 1024ull * 1024 * 2;
constexpr size_t BT_VW = BT_QK + 48ull * 256 * 1024 * 2;
constexpr size_t WS_END = BT_VW + 12ull * 1024 * 1024 * 2;
static_assert(R0_END <= SLOT_A, "region 0 overflow");
constexpr size_t HALF_SLOT = 80 * MB1;

constexpr int STAGE_BYTES = 131072;
constexpr int LDS_BYTES = STAGE_BYTES + 8192 + 256;

struct Params {
    const float* in[29];
    float* out;
    unsigned char* ws;
    int ph_lo, ph_hi;
};

__device__ __forceinline__ int fresh_tid(const int w0) { int t = w0 * 64 + (int)__builtin_amdgcn_mbcnt_hi(~0u, __builtin_amdgcn_mbcnt_lo(~0u, 0u)); asm volatile("" : "+v"(t)); return t; }
__device__ __forceinline__ unsigned cvt_pk_bf16(float lo, float hi) { unsigned r; asm("v_cvt_pk_bf16_f32 %0, %1, %2" : "=v"(r) : "v"(lo), "v"(hi)); return r; }
__device__ __forceinline__ float bf_lo(unsigned w) { return __uint_as_float(w << 16); }
__device__ __forceinline__ float bf_hi(unsigned w) { return __uint_as_float(w & 0xffff0000u); }
__device__ __forceinline__ void unpack8(const u32x4 w, f32x4& a, f32x4& b) {
    a = (f32x4){bf_lo(w.x), bf_hi(w.x), bf_lo(w.y), bf_hi(w.y)};
    b = (f32x4){bf_lo(w.z), bf_hi(w.z), bf_lo(w.w), bf_hi(w.w)};
}
__device__ __forceinline__ u32x4 pack8(const f32x4 a, const f32x4 b) {
    u32x4 w; w.x = cvt_pk_bf16(a[0], a[1]); w.y = cvt_pk_bf16(a[2], a[3]); w.z = cvt_pk_bf16(b[0], b[1]); w.w = cvt_pk_bf16(b[2], b[3]); return w;
}
__device__ __forceinline__ float sigmoidf_(float x) { return __builtin_amdgcn_rcpf(1.0f + __expf(-x)); }
__device__ __forceinline__ f32x4 sigmoid4(f32x4 x) { return (f32x4){sigmoidf_(x[0]), sigmoidf_(x[1]), sigmoidf_(x[2]), sigmoidf_(x[3])}; }
__device__ __forceinline__ float gelu_tanh(float x) { const float t = 1.5957691216057308f * (x + 0.044715f * x * x * x); return x * sigmoidf_(t); }
__device__ __forceinline__ f32x4 gelu4(f32x4 x) { return (f32x4){gelu_tanh(x[0]), gelu_tanh(x[1]), gelu_tanh(x[2]), gelu_tanh(x[3])}; }
__device__ __forceinline__ float wave_sum(float v) {
#pragma unroll
    for (int o = 1; o < 64; o <<= 1) v += __shfl_xor(v, o);
    return v;
}
__device__ __forceinline__ float rinv_from_ssq4(const float* ssq, int row) {
    const f32x4 s = (f32x4){ssq[row], ssq[M + row], ssq[2 * M + row], ssq[3 * M + row]};
    return rsqrtf(((s[0] + s[1]) + (s[2] + s[3])) * (1.0f / 1024.0f) + EPS);
}
__device__ __forceinline__ int batch_of_tile(int pm) { return pm < 256 ? (pm >> 5) : 8 + ((pm - 256) >> 4); }


__device__ __forceinline__ unsigned xb_add(unsigned* p, unsigned v) { return __hip_atomic_fetch_add(p, v, __ATOMIC_RELAXED, __HIP_MEMORY_SCOPE_AGENT); }
__device__ __forceinline__ unsigned xb_read(unsigned* p) { unsigned z = 0u; asm volatile("" : "+s"(z)); return __hip_atomic_fetch_add(p, z, __ATOMIC_RELAXED, __HIP_MEMORY_SCOPE_AGENT); }
#define HB_CTR      64
#define HB_XCNT(j)  (128  + 64 * (j))
#define HB_XSUB(j)  (1152 + 64 * (j))
#define HB_XGEN(j)  (2176 + 64 * (j))
#define HB_TOP      3200
#define HB_TOPGEN   3264
#define HB_WORDS    3328
__device__ __forceinline__ unsigned hb_xcc() { return (unsigned)__builtin_amdgcn_s_getreg((3 << 11) | 20) & 0xFu; }
__device__ __forceinline__ void hier_barrier(unsigned* bar, volatile LAS unsigned* lw, const unsigned r, const int w0) {
    asm volatile("s_waitcnt vmcnt(0) lgkmcnt(0)" ::: "memory");
    __syncthreads();
    if (w0 == 0 && __builtin_amdgcn_mbcnt_hi(~0u, __builtin_amdgcn_mbcnt_lo(~0u, 0u)) == 0u) {
        const unsigned x = hb_xcc(), nloc = lw[1], nx = lw[2];
        const unsigned old = xb_add(&bar[HB_XSUB(x)], 1u) - lw[3];
        unsigned sp = 0u;
        if (old + 1u == r * nloc) {
            __builtin_amdgcn_fence(__ATOMIC_RELEASE, "agent");
            asm volatile("s_waitcnt vmcnt(0)" ::: "memory");
            const unsigned og = xb_add(&bar[HB_TOP], 1u) - lw[5];
            if (og + 1u == r * nx) (void)xb_add(&bar[HB_TOPGEN], 1u);
            else while ((int)(xb_read(&bar[HB_TOPGEN]) - lw[6] - r) < 0) { __builtin_amdgcn_s_sleep(2); if (++sp > (1u << 24)) break; }
            __builtin_amdgcn_fence(__ATOMIC_ACQUIRE, "agent");
            (void)xb_add(&bar[HB_XGEN(x)], 1u);
            asm volatile("s_waitcnt vmcnt(0)" ::: "memory");
        } else {
            while ((int)(xb_read(&bar[HB_XGEN(x)]) - lw[4] - r) < 0) { __builtin_amdgcn_s_sleep(2); if (++sp > (1u << 24)) break; }
            __builtin_amdgcn_fence(__ATOMIC_ACQUIRE, "agent");
            asm volatile("s_waitcnt vmcnt(0)" ::: "memory");
        }
    }
    __syncthreads();
}
__device__ __forceinline__ void ctr_barrier(unsigned* ctr, volatile LAS unsigned* basew, const unsigned k, const int w0) {
    asm volatile("s_waitcnt vmcnt(0) lgkmcnt(0)" ::: "memory");
    __syncthreads();
    if (w0 == 0 && __builtin_amdgcn_mbcnt_hi(~0u, __builtin_amdgcn_mbcnt_lo(~0u, 0u)) == 0u) {
        __builtin_amdgcn_fence(__ATOMIC_RELEASE, "agent");
        asm volatile("s_waitcnt vmcnt(0)" ::: "memory");
        const unsigned target = basew[0] + k * gridDim.x;
        unsigned cur = xb_add(ctr, 1u) + 1u;
        unsigned sp = 0u;
        while ((int)(cur - target) < 0) { __builtin_amdgcn_s_sleep(20); cur = xb_read(ctr); if (++sp > (1u << 22)) break; }
        __builtin_amdgcn_fence(__ATOMIC_ACQUIRE, "agent");
        asm volatile("s_waitcnt vmcnt(0)" ::: "memory");
    }
    __syncthreads();
}

constexpr int BM = 256, BK = 64, HALF = 128, HTB = HALF * BK * 2;
__device__ __forceinline__ int lds_byte(int r, int c) { const int st = (r >> 4) * 2 + (c >> 5), rr = r & 15, cc = c & 31, ob = rr * 64 + cc * 2; return st * 1024 + (ob ^ (((ob >> 9) & 1) << 5)); }
__device__ __forceinline__ void stage_rc(int b, int& R, int& C) { const int st = b / 1024, sb = b % 1024, swz = sb ^ (((sb >> 9) & 1) << 5); R = (st >> 1) * 16 + swz / 64; C = (st & 1) * 32 + (swz % 64) / 2; }
__device__ __forceinline__ int perm32(int rho) { const int n = rho >> 4, i = rho & 15; return 8 * (i >> 2) + 4 * n + (i & 3); }

struct Unit { int pm, pn; const char* a; const char* b; };

template <class Epi, class Map>
__device__ __forceinline__ void gemm_phase(LAS unsigned char* lds, const int nM, const int nN, const int lda2, const int ldb2, const int K, const Map& map, const Epi& E, const int c, const int G, const int w0, const int astr = 0) {
    const int tid = fresh_tid(w0), wid = __builtin_amdgcn_readfirstlane(tid >> 6), lane = tid & 63, wr = wid >> 2, wc = wid & 3, fr = lane & 15, fq = lane >> 4;
    const int nt = K / BK, nwg = nM * nN;
    auto next = [&](int i, Unit& u) -> bool {
        const long L = (long)i * G + c; if (L >= nwg) return false;
        int wgid = (int)L; { const int q = nwg / 8, r = nwg % 8, xcd = wgid % 8, off = wgid / 8; wgid = (xcd < r ? xcd * (q + 1) : r * (q + 1) + (xcd - r) * q) + off; }
        const int nig = 8 * nN, gid = wgid / nig, fm = gid * 8, gsz = (nM - fm) < 8 ? (nM - fm) : 8;
        u.pm = fm + ((wgid % nig) % gsz); u.pn = (wgid % nig) / gsz; map(u); return true;
    };
    unsigned voffA[2], voffB[2];
#pragma unroll
    for (int i = 0; i < 2; ++i) { int R, C; stage_rc(tid * 16 + i * 8192, R, C); const int Rb = (R & ~31) + perm32(R & 31);
        voffA[i] = astr ? (unsigned)((C >> 4) * lda2 + R * 32 + (C & 15) * 2) : (unsigned)(R * lda2 + C * 2); voffB[i] = (unsigned)(Rb * ldb2 + C * 2); }
    const size_t kstep = (size_t)(BK * 2);
    const size_t hstepA = astr ? (size_t)HALF * 32 : (size_t)HALF * lda2, hstepB = (size_t)HALF * ldb2;
    const size_t kstepA = astr ? (size_t)4 * lda2 : kstep;
    const unsigned ldsw = (unsigned)wid * 1024u;
    const int aoff = lds_byte(wr * 64 + fr, fq * 8), boff = lds_byte(wc * 32 + fr, fq * 8);
#define PG8_SA(b, h) (((b) * 2 + (h)) * HTB)
#define PG8_SB(b, h) ((4 + (b) * 2 + (h)) * HTB)
#define PG8_STAGE(bufoff, gbase, voff) do { _Pragma("unroll") for (int _i = 0; _i < 2; ++_i) \
        __builtin_amdgcn_global_load_lds((const unsigned*)((const char*)(gbase) + (voff)[_i]), (LAS unsigned*)(lds + (bufoff) + ldsw + _i * 8192), 16, 0, 0); } while (0)
#define PG8_LDA(dst, b, h) do { _Pragma("unroll") for (int m = 0; m < 4; ++m) _Pragma("unroll") for (int k = 0; k < 2; ++k) dst[m][k] = *(const LAS bf16x8*)(lds + PG8_SA(b, h) + aoff + m * 2048 + k * 1024); } while (0)
#define PG8_LDB(dst, b, h) do { _Pragma("unroll") for (int n = 0; n < 2; ++n) _Pragma("unroll") for (int k = 0; k < 2; ++k) dst[n][k] = *(const LAS bf16x8*)(lds + PG8_SB(b, h) + boff + n * 2048 + k * 1024); } while (0)
#define PG8_MMA(ai, bj, At, Bt) do { __builtin_amdgcn_s_setprio(1); _Pragma("unroll") for (int m = 0; m < 4; ++m) _Pragma("unroll") for (int n = 0; n < 2; ++n) _Pragma("unroll") for (int k = 0; k < 2; ++k) \
        acc[ai][bj][m][n] = __builtin_amdgcn_mfma_f32_16x16x32_bf16(Bt[n][k], At[m][k], acc[ai][bj][m][n], 0, 0, 0); __builtin_amdgcn_s_setprio(0); } while (0)
#define PG8_WAIT_V(n) asm volatile("s_waitcnt vmcnt(" #n ")" ::: "memory")
#define PG8_WAIT_L(n) asm volatile("s_waitcnt lgkmcnt(" #n ")" ::: "memory")
#define PG8_BAR __builtin_amdgcn_s_barrier()
#define PG8_SCHED __builtin_amdgcn_sched_barrier(0)
    Unit cur, nxt; int ui = 0;
    if (!next(0, cur)) return;
    f32x4 acc[2][2][4][2];
#pragma unroll
    for (int a = 0; a < 2; ++a)
#pragma unroll
        for (int b = 0; b < 2; ++b)
#pragma unroll
            for (int m = 0; m < 4; ++m)
#pragma unroll
                for (int n = 0; n < 2; ++n) acc[a][b][m][n] = (f32x4){0.f, 0.f, 0.f, 0.f};
    bf16x8 At[4][2], B0[2][2], B1[2][2];
    const char* cA = cur.a; const char* cB = cur.b;
    PG8_STAGE(PG8_SB(0, 0), cB, voffB); PG8_STAGE(PG8_SA(0, 0), cA, voffA); PG8_STAGE(PG8_SB(0, 1), cB + hstepB, voffB); PG8_STAGE(PG8_SA(0, 1), cA + hstepA, voffA);
    if (wr == 1) PG8_BAR;
    PG8_WAIT_V(4); PG8_BAR;
    PG8_STAGE(PG8_SB(1, 0), cB + kstep, voffB); PG8_STAGE(PG8_SA(1, 0), cA + kstepA, voffA); PG8_STAGE(PG8_SB(1, 1), cB + hstepB + kstep, voffB);
    PG8_WAIT_V(6); PG8_BAR;
    for (;;) {
        const bool has_next = next(ui + 1, nxt);
        const char* nA = has_next ? nxt.a : cA; const char* nB = has_next ? nxt.b : cB;
        for (int t = 0; t < nt; t += 2) {
            const bool last = (t == nt - 2);
            const char* a1 = cA + (size_t)(t + 1) * kstepA;
            const char* a2 = last ? nA : cA + (size_t)(t + 2) * kstepA; const char* b2 = last ? nB : cB + (size_t)(t + 2) * kstep;
            const char* a3 = a2 + kstepA; const char* b3 = b2 + kstep;
            PG8_LDB(B0, 0, 0); PG8_SCHED; PG8_LDA(At, 0, 0); PG8_STAGE(PG8_SA(1, 1), a1 + hstepA, voffA);
            PG8_WAIT_L(8); PG8_BAR; PG8_WAIT_L(0); PG8_MMA(0, 0, At, B0); PG8_BAR; PG8_SCHED;
            PG8_LDB(B1, 0, 1); PG8_STAGE(PG8_SB(0, 0), b2, voffB);
            PG8_BAR; PG8_WAIT_L(0); PG8_MMA(0, 1, At, B1); PG8_BAR;
            PG8_LDA(At, 0, 1); PG8_STAGE(PG8_SA(0, 0), a2, voffA);
            PG8_BAR; PG8_WAIT_L(0); PG8_MMA(1, 0, At, B0); PG8_BAR; PG8_SCHED;
            PG8_STAGE(PG8_SB(0, 1), b2 + hstepB, voffB);
            PG8_WAIT_V(6); PG8_BAR; PG8_MMA(1, 1, At, B1); PG8_BAR;
            PG8_LDB(B0, 1, 0); PG8_SCHED; PG8_LDA(At, 1, 0); PG8_STAGE(PG8_SA(0, 1), a2 + hstepA, voffA);
            PG8_WAIT_L(8); PG8_BAR; PG8_WAIT_L(0); PG8_MMA(0, 0, At, B0); PG8_BAR; PG8_SCHED;
            PG8_LDB(B1, 1, 1); PG8_STAGE(PG8_SB(1, 0), b3, voffB);
            PG8_BAR; PG8_WAIT_L(0); PG8_MMA(0, 1, At, B1); PG8_BAR;
            PG8_LDA(At, 1, 1); PG8_STAGE(PG8_SA(1, 0), a3, voffA);
            PG8_BAR; PG8_WAIT_L(0); PG8_MMA(1, 0, At, B0); PG8_BAR; PG8_SCHED;
            PG8_STAGE(PG8_SB(1, 1), b3 + hstepB, voffB);
            PG8_WAIT_V(6); PG8_BAR; PG8_MMA(1, 1, At, B1); PG8_BAR;
        }
        { int frl = fr, fql = fq; asm volatile("" : "+v"(frl), "+v"(fql)); E(acc, cur, wr, wc, frl, fql); }
        if (!has_next) break;
#pragma unroll
        for (int a = 0; a < 2; ++a)
#pragma unroll
            for (int b = 0; b < 2; ++b)
#pragma unroll
                for (int m = 0; m < 4; ++m)
#pragma unroll
                    for (int n = 0; n < 2; ++n) acc[a][b][m][n] = (f32x4){0.f, 0.f, 0.f, 0.f};
        cur = nxt; cA = nA; cB = nB; ++ui;
    }
    PG8_WAIT_V(0);
    if (wr == 0) PG8_BAR;
    PG8_BAR;
#undef PG8_SA
#undef PG8_SB
#undef PG8_STAGE
#undef PG8_LDA
#undef PG8_LDB
#undef PG8_MMA
#undef PG8_WAIT_V
#undef PG8_WAIT_L
#undef PG8_BAR
#undef PG8_SCHED
}

__device__ __forceinline__ bool row_fence() { asm volatile("" ::: "memory"); return true; }
#define EPI_ARGS const f32x4 (&acc)[2][2][4][2], const Unit& u, int wr, int wc, int fr, int fq
#define FOR_AI _Pragma("unroll") for (int ai = 0; ai < 2; ++ai) if (row_fence())
#define FOR_M _Pragma("unroll") for (int m = 0; m < 4; ++m)
#define FOR_AI_M_NF _Pragma("unroll") for (int ai = 0; ai < 2; ++ai) _Pragma("unroll") for (int m = 0; m < 4; ++m)
#define FOR_BJ _Pragma("unroll") for (int bj = 0; bj < 2; ++bj)

struct EpiIn {
    bf16_t* acat; bf16_t* z; bf16_t* gb; bf16_t* gates; const float* rinv; const float* bgate;
    __device__ __forceinline__ void operator()(EPI_ARGS) const {
        const int row0 = u.pm * BM + wr * 64 + fr, colw = wc * 32 + 8 * fq, pn = u.pn;
        float rv[2][4];
        FOR_AI_M_NF { const int rr = row0 + ai * HALF + m * 16; rv[ai][m] = rinv[(size_t)(rr >> 1) * 32 + (rr & 1)]; }
        if (pn < 2) {
            FOR_AI FOR_M { const int row = row0 + ai * HALF + m * 16; const float r = rv[ai][m]; const int cr = row >> 5, j = row & 31;
                FOR_BJ { const int col = pn * 256 + bj * HALF + colw; const int g = col >> 4, p = col & 15;
                    *(u32x4*)(acat + ((size_t)(cr * NG + g) * KCAT + 256 + j * 16 + p)) = pack8(acc[ai][bj][m][0] * r, acc[ai][bj][m][1] * r); } }
        } else if (pn < 6) {
            FOR_AI FOR_M { const int row = row0 + ai * HALF + m * 16; const float r = rv[ai][m]; const float r2 = r * r;
                *(u32x4*)(z + (size_t)row * 512 + (pn - 2) * HALF + colw) = pack8(acc[ai][0][m][0] * acc[ai][1][m][0] * r2, acc[ai][0][m][1] * acc[ai][1][m][1] * r2); }
        } else if (pn < 8) {
            FOR_AI FOR_M { const int row = row0 + ai * HALF + m * 16; const float r = rv[ai][m];
                FOR_BJ *(u32x4*)(gb + (size_t)row * 512 + (pn - 6) * 256 + bj * HALF + colw) = pack8(acc[ai][bj][m][0] * r, acc[ai][bj][m][1] * r); }
        } else {
            f32x4 bv[2][2];
            FOR_BJ { const float* bp = bgate + (pn - 8) * 256 + bj * HALF + colw; bv[bj][0] = *(const f32x4*)bp; bv[bj][1] = *(const f32x4*)(bp + 4); }
            FOR_AI FOR_M { const int row = row0 + ai * HALF + m * 16; const float r = rv[ai][m];
                FOR_BJ *(u32x4*)(gates + (size_t)row * 2048 + (pn - 8) * 256 + bj * HALF + colw) = pack8(sigmoid4(acc[ai][bj][m][0] * r + bv[bj][0]), sigmoid4(acc[ai][bj][m][1] * r + bv[bj][1])); }
        }
    }
};
struct EpiKV {
    bf16_t* kk; bf16_t* vt; const float* rinv;
    __device__ __forceinline__ void operator()(EPI_ARGS) const {
        const int row0 = u.pm * BM + wr * 64 + fr, colw = wc * 32 + 8 * fq, pn = u.pn;
        float rv[2][4];
        FOR_AI_M_NF { const int rr = row0 + ai * HALF + m * 16; rv[ai][m] = rinv[(size_t)(rr >> 1) * 32 + (rr & 1)]; }
        if (pn < 4) {
            FOR_AI FOR_M { const int row = row0 + ai * HALF + m * 16; const float r = rv[ai][m];
                FOR_BJ *(u32x4*)(kk + (size_t)row * 1024 + pn * 256 + bj * HALF + colw) = pack8(acc[ai][bj][m][0] * r, acc[ai][bj][m][1] * r); }
        } else {
            FOR_AI FOR_M { const int row = row0 + ai * HALF + m * 16; const float r = rv[ai][m];
                FOR_BJ *(u32x4*)(vt + (size_t)row * 1024 + (pn - 4) * 256 + bj * HALF + colw) = pack8(acc[ai][bj][m][0] * r, acc[ai][bj][m][1] * r); }
        }
    }
};
struct EpiState {
    float* S;
    __device__ __forceinline__ void operator()(EPI_ARGS) const {
        const int row0 = u.pm * BM + wr * 64 + fr, colw = wc * 32 + 8 * fq, g = u.pn;
        FOR_AI FOR_M { const int row = row0 + ai * HALF + m * 16;
            FOR_BJ { float* p = S + ((size_t)row * NG + g) * 256 + bj * HALF + colw; *(f32x4*)p = acc[ai][bj][m][0]; *(f32x4*)(p + 4) = acc[ai][bj][m][1]; } }
    }
};
struct EpiY {
    bf16_t* yb;
    __device__ __forceinline__ void operator()(EPI_ARGS) const {
        const int row0 = u.pm * BM + wr * 64 + fr, colw = wc * 32 + 8 * fq, g = u.pn >> 1, pn2 = u.pn & 1;
        FOR_AI FOR_M { const int row = row0 + ai * HALF + m * 16;
            FOR_BJ { const int n = pn2 * 256 + bj * HALF + colw; const int j = n >> 4, p = n & 15;
                *(u32x4*)(yb + ((size_t)g * M + (size_t)row * LC + j) * 16 + p) = pack8(gelu4(acc[ai][bj][m][0]), gelu4(acc[ai][bj][m][1])); } }
    }
};
struct EpiConv {
    bf16_t* part; const bf16_t* gates;
    __device__ __forceinline__ void operator()(EPI_ARGS) const {
        const int row0 = u.pm * BM + wr * 64 + fr, colw = wc * 32 + 8 * fq;
        FOR_AI { u32x4 gw[4][2];
            FOR_M FOR_BJ gw[m][bj] = *(const u32x4*)(gates + (size_t)(row0 + ai * HALF + m * 16) * 2048 + 1024 + u.pn * 256 + bj * HALF + colw);
            FOR_M { const int row = row0 + ai * HALF + m * 16;
                FOR_BJ { const int col = u.pn * 256 + bj * HALF + colw; f32x4 g0, g1; unpack8(gw[m][bj], g0, g1);
                    *(u32x4*)(part + (size_t)row * 1024 + col) = pack8(acc[ai][bj][m][0] * g0, acc[ai][bj][m][1] * g1); } } }
    }
};
struct EpiGlu {
    const bf16_t* part; const bf16_t* gates; bf16_t* merged;
    __device__ __forceinline__ void operator()(EPI_ARGS) const {
        const int row0 = u.pm * BM + wr * 64 + fr, colw = wc * 32 + 8 * fq, col = u.pn * HALF + colw;
        FOR_AI { u32x4 gw[4], pw[4];
            FOR_M { const int row = row0 + ai * HALF + m * 16; gw[m] = *(const u32x4*)(gates + (size_t)row * 2048 + col); pw[m] = *(const u32x4*)(part + (size_t)row * 1024 + col); }
            FOR_M { const int row = row0 + ai * HALF + m * 16; f32x4 g0, g1, p0, p1; unpack8(gw[m], g0, g1); unpack8(pw[m], p0, p1);
                *(u32x4*)(merged + (size_t)row * 1024 + col) = pack8(g0 * acc[ai][0][m][0] * sigmoid4(acc[ai][1][m][0]) + p0, g1 * acc[ai][0][m][1] * sigmoid4(acc[ai][1][m][1]) + p1); } }
    }
};
__device__ __forceinline__ void ssq_exchange(const float (&sv)[2][4], LAS float* xch, float* ssq, const Unit& u, int wr, int wc, int fr, int fq) {
    const int rloc0 = wr * 64 + fr;
    if (fq == 0) { FOR_AI_M_NF xch[(rloc0 + ai * HALF + m * 16) * 4 + wc] = sv[ai][m]; }
    asm volatile("s_waitcnt lgkmcnt(0)" ::: "memory"); __builtin_amdgcn_s_barrier(); asm volatile("" ::: "memory");
    if (wc == 0 && fq == 0) { FOR_AI_M_NF { const int rl = rloc0 + ai * HALF + m * 16; const f32x4 w = *(const LAS f32x4*)(xch + rl * 4);
        ssq[(size_t)u.pn * M + (u.pm * BM + rl)] = (w[0] + w[1]) + (w[2] + w[3]); } }
}
__device__ __forceinline__ float rinv_from4(const f32x4 s) { return rsqrtf(((s[0] + s[1]) + (s[2] + s[3])) * (1.0f / 1024.0f) + EPS); }
struct EpiRes {
    const bf16_t* res; bf16_t* hb; float* ssq; LAS float* xch;
    __device__ __forceinline__ void operator()(EPI_ARGS) const {
        const int row0 = u.pm * BM + wr * 64 + fr, colw = wc * 32 + 8 * fq;
        float sv[2][4];
        FOR_AI { u32x4 rw[4][2];
            FOR_M FOR_BJ rw[m][bj] = *(const u32x4*)(res + (size_t)(row0 + ai * HALF + m * 16) * 1024 + u.pn * 256 + bj * HALF + colw);
            FOR_M { const int row = row0 + ai * HALF + m * 16; float s = 0.f;
                FOR_BJ { const int col = u.pn * 256 + bj * HALF + colw; f32x4 r0, r1; unpack8(rw[m][bj], r0, r1);
                    const f32x4 v0 = r0 + acc[ai][bj][m][0], v1 = r1 + acc[ai][bj][m][1];
                    s += (v0[0] * v0[0] + v0[1] * v0[1]) + (v0[2] * v0[2] + v0[3] * v0[3]) + (v1[0] * v1[0] + v1[1] * v1[1]) + (v1[2] * v1[2] + v1[3] * v1[3]);
                    *(u32x4*)(hb + (size_t)row * 1024 + col) = pack8(v0, v1); }
                s += __shfl_xor(s, 16); s += __shfl_xor(s, 32); sv[ai][m] = s; } }
        ssq_exchange(sv, xch, ssq, u, wr, wc, fr, fq);
    }
};
struct EpiQ {
    bf16_t* q; const float* ssq;
    __device__ __forceinline__ void operator()(EPI_ARGS) const {
        const int row0 = u.pm * BM + wr * 64 + fr, colw = wc * 32 + 8 * fq;
        f32x4 s4[2][4];
        FOR_AI_M_NF { const float* sp = ssq + (row0 + ai * HALF + m * 16); s4[ai][m] = (f32x4){sp[0], sp[M], sp[2 * M], sp[3 * M]}; }
        FOR_AI FOR_M { const int row = row0 + ai * HALF + m * 16; const float r = rinv_from4(s4[ai][m]);
            FOR_BJ *(u32x4*)(q + (size_t)row * 1024 + u.pn * 256 + bj * HALF + colw) = pack8(acc[ai][bj][m][0] * r, acc[ai][bj][m][1] * r); }
    }
};
struct EpiSoftmax {
    bf16_t* P; float* lpart; LAS float* xch;
    __device__ __forceinline__ void operator()(EPI_ARGS) const {
        const int rloc0 = wr * 64 + fr, colw = wc * 32 + 8 * fq;
        FOR_AI_M_NF { float v = -3.0e38f;
            FOR_BJ { const f32x4 a = acc[ai][bj][m][0], b = acc[ai][bj][m][1];
                v = fmaxf(v, fmaxf(fmaxf(fmaxf(a[0], a[1]), fmaxf(a[2], a[3])), fmaxf(fmaxf(b[0], b[1]), fmaxf(b[2], b[3])))); }
            v = fmaxf(v, __shfl_xor(v, 16)); v = fmaxf(v, __shfl_xor(v, 32));
            if (fq == 0) xch[(rloc0 + ai * HALF + m * 16) * 4 + wc] = v; }
        asm volatile("s_waitcnt lgkmcnt(0)" ::: "memory"); __builtin_amdgcn_s_barrier(); asm volatile("" ::: "memory");
        FOR_AI FOR_M { const int rl = rloc0 + ai * HALF + m * 16; const f32x4 w = *(const LAS f32x4*)(xch + rl * 4);
            const float mxx = fmaxf(fmaxf(w[0], w[1]), fmaxf(w[2], w[3])); const int row = u.pm * BM + rl; float s = 0.f;
            FOR_BJ { f32x4 a = acc[ai][bj][m][0], b = acc[ai][bj][m][1];
#pragma unroll
                for (int e = 0; e < 4; ++e) { a[e] = __expf(a[e] - mxx); b[e] = __expf(b[e] - mxx); }
                s += (a[0] + a[1]) + (a[2] + a[3]) + (b[0] + b[1]) + (b[2] + b[3]);
                *(u32x4*)(P + (size_t)row * 1024 + u.pn * 256 + bj * HALF + colw) = pack8(a, b); }
            s += __shfl_xor(s, 16); s += __shfl_xor(s, 32);
            if (fq == 0) lpart[(size_t)row * 16 + u.pn * 4 + wc] = s; }
    }
};
struct EpiPlain {
    bf16_t* out;
    __device__ __forceinline__ void operator()(EPI_ARGS) const {
        const int row0 = u.pm * BM + wr * 64 + fr, colw = wc * 32 + 8 * fq;
        FOR_AI FOR_M { const int row = row0 + ai * HALF + m * 16;
            FOR_BJ *(u32x4*)(out + (size_t)row * 1024 + u.pn * 256 + bj * HALF + colw) = pack8(acc[ai][bj][m][0], acc[ai][bj][m][1]); }
    }
};
struct EpiVW {
    bf16_t* out;
    __device__ __forceinline__ void operator()(EPI_ARGS) const {
        const int rloc0 = wr * 64 + fr, colw = wc * 32 + 8 * fq, b = u.pm >> 2, h = u.pm & 3;
        FOR_AI FOR_M { const int n = u.pn * BM + rloc0 + ai * HALF + m * 16;
            FOR_BJ *(u32x4*)(out + ((size_t)b * 1024 + n) * 1024 + h * 256 + bj * HALF + colw) = pack8(acc[ai][bj][m][0], acc[ai][bj][m][1]); }
    }
};
struct EpiSoftmaxR {
    bf16_t* P; LAS float* xch; const float* ssq;
    __device__ __forceinline__ void operator()(EPI_ARGS) const {
        f32x4 (&ex)[2][2][4][2] = const_cast<f32x4 (&)[2][2][4][2]>(acc);
        const int rloc0 = wr * 64 + fr, colw = wc * 32 + 8 * fq;
        float rv[2][4];
        { f32x4 s4[2][4];
          FOR_AI_M_NF { const float* sp = ssq + (u.pm * BM + rloc0 + ai * HALF + m * 16); s4[ai][m] = (f32x4){sp[0], sp[M], sp[2 * M], sp[3 * M]}; }
          FOR_AI_M_NF rv[ai][m] = rinv_from4(s4[ai][m]); }
        FOR_AI FOR_M { const float r = rv[ai][m]; float v = -3.0e38f;
            FOR_BJ { const f32x4 a = ex[ai][bj][m][0], b = ex[ai][bj][m][1];
                v = fmaxf(v, fmaxf(fmaxf(fmaxf(a[0], a[1]), fmaxf(a[2], a[3])), fmaxf(fmaxf(b[0], b[1]), fmaxf(b[2], b[3])))); }
            v = fmaxf(v, __shfl_xor(v, 16)); v = fmaxf(v, __shfl_xor(v, 32));
            const float mw = v * r; float s = 0.f;
            FOR_BJ { f32x4 a = ex[ai][bj][m][0], b = ex[ai][bj][m][1];
#pragma unroll
                for (int e = 0; e < 4; ++e) { a[e] = __expf(a[e] * r - mw); b[e] = __expf(b[e] * r - mw); }
                s += (a[0] + a[1]) + (a[2] + a[3]) + (b[0] + b[1]) + (b[2] + b[3]);
                ex[ai][bj][m][0] = a; ex[ai][bj][m][1] = b; }
            s += __shfl_xor(s, 16); s += __shfl_xor(s, 32);
            if (fq == 0) { const int rl = rloc0 + ai * HALF + m * 16; xch[rl * 8 + wc * 2] = mw; xch[rl * 8 + wc * 2 + 1] = s; } }
        asm volatile("s_waitcnt lgkmcnt(0)" ::: "memory"); __builtin_amdgcn_s_barrier(); asm volatile("" ::: "memory");
        FOR_AI FOR_M { const int rl = rloc0 + ai * HALF + m * 16;
            const f32x4 w0v = *(const LAS f32x4*)(xch + rl * 8), w1v = *(const LAS f32x4*)(xch + rl * 8 + 4);
            const float mx = fmaxf(fmaxf(w0v[0], w0v[2]), fmaxf(w1v[0], w1v[2]));
            const float l = (w0v[1] * __expf(w0v[0] - mx) + w0v[3] * __expf(w0v[2] - mx)) + (w1v[1] * __expf(w1v[0] - mx) + w1v[3] * __expf(w1v[2] - mx));
            const float mown = wc == 0 ? w0v[0] : (wc == 1 ? w0v[2] : (wc == 2 ? w1v[0] : w1v[2]));
            const float c = __expf(mown - mx) * __builtin_amdgcn_rcpf(l); const int row = u.pm * BM + rl;
            FOR_BJ *(u32x4*)(P + (size_t)row * 1024 + u.pn * 256 + bj * HALF + colw) = pack8(ex[ai][bj][m][0] * c, ex[ai][bj][m][1] * c); }
    }
};
struct EpiPV {
    bf16_t* o; const float* lpart;
    __device__ __forceinline__ void operator()(EPI_ARGS) const {
        const int row0 = u.pm * BM + wr * 64 + fr, colw = wc * 32 + 8 * fq;
        f32x4 l4[2][4];
        FOR_AI_M_NF l4[ai][m] = *(const f32x4*)(lpart + (size_t)(row0 + ai * HALF + m * 16) * 16 + u.pn * 4);
        FOR_AI FOR_M { const int row = row0 + ai * HALF + m * 16; const f32x4 l = l4[ai][m];
            const float r = __builtin_amdgcn_rcpf((l[0] + l[1]) + (l[2] + l[3]));
            FOR_BJ *(u32x4*)(o + (size_t)row * 1024 + u.pn * 256 + bj * HALF + colw) = pack8(acc[ai][bj][m][0] * r, acc[ai][bj][m][1] * r); }
    }
};
struct EpiGU {
    bf16_t* act; const float* ssq;
    __device__ __forceinline__ void operator()(EPI_ARGS) const {
        const int row0 = u.pm * BM + wr * 64 + fr, colw = wc * 32 + 8 * fq;
        f32x4 s4[2][4];
        FOR_AI_M_NF { const float* sp = ssq + (row0 + ai * HALF + m * 16); s4[ai][m] = (f32x4){sp[0], sp[M], sp[2 * M], sp[3 * M]}; }
        FOR_AI FOR_M { const int row = row0 + ai * HALF + m * 16; const float r = rinv_from4(s4[ai][m]);
            const f32x4 g0 = acc[ai][0][m][0] * r, g1 = acc[ai][0][m][1] * r, u0 = acc[ai][1][m][0] * r, u1 = acc[ai][1][m][1] * r;
            *(u32x4*)(act + (size_t)row * DFF + u.pn * HALF + colw) = pack8(g0 * sigmoid4(g0) * u0, g1 * sigmoid4(g1) * u1); }
    }
};
struct EpiDown {
    const bf16_t* res; bf16_t* hb; float* ssq; LAS float* xch;
    __device__ __forceinline__ void operator()(EPI_ARGS) const {
        const int row0 = u.pm * BM + wr * 64 + fr, colw = wc * 32 + 8 * fq;
        float sv[2][4];
        FOR_AI { u32x4 rw[4][2];
            FOR_M FOR_BJ rw[m][bj] = *(const u32x4*)(res + (size_t)(row0 + ai * HALF + m * 16) * 1024 + u.pn * 256 + bj * HALF + colw);
            FOR_M { const int row = row0 + ai * HALF + m * 16; float s = 0.f;
                FOR_BJ { const int col = u.pn * 256 + bj * HALF + colw; f32x4 r0, r1; unpack8(rw[m][bj], r0, r1);
                    const f32x4 v0 = r0 + acc[ai][bj][m][0], v1 = r1 + acc[ai][bj][m][1];
                    const u32x4 w = pack8(v0, v1); f32x4 q0, q1; unpack8(w, q0, q1);
                    s += (q0[0] * q0[0] + q0[1] * q0[1]) + (q0[2] * q0[2] + q0[3] * q0[3]) + (q1[0] * q1[0] + q1[1] * q1[1]) + (q1[2] * q1[2] + q1[3] * q1[3]);
                    *(u32x4*)(hb + (size_t)row * 1024 + col) = w; }
                s += __shfl_xor(s, 16); s += __shfl_xor(s, 32); sv[ai][m] = s; } }
        ssq_exchange(sv, xch, ssq, u, wr, wc, fr, fq);
    }
};

struct MapPlain { const char* A; const char* B; size_t ta, tb; __device__ __forceinline__ void operator()(Unit& u) const { u.a = A + (size_t)u.pm * ta; u.b = B + (size_t)u.pn * tb; } };
struct MapState { const char* acat; const char* bt; __device__ __forceinline__ void operator()(Unit& u) const {
        u.a = acat + ((size_t)u.pm * 256 * NG * KCAT + (size_t)u.pn * KCAT + 256) * 2; u.b = bt + (size_t)u.pn * 256 * 512 * 2; } };
struct MapY { const char* acat; const char* bt; __device__ __forceinline__ void operator()(Unit& u) const {
        const int g = u.pn >> 1; u.a = acat + ((size_t)u.pm * 256 * NG * KCAT + (size_t)g * KCAT) * 2; u.b = bt + ((size_t)g * 512 + (u.pn & 1) * 256) * KCAT * 2; } };
struct MapQK { const char* kk; const char* wqn; __device__ __forceinline__ void operator()(Unit& u) const {
        const int b = u.pm >> 2, h = u.pm & 3; u.a = kk + ((size_t)b * 256 * 1024 + h * 256) * 2; u.b = wqn + ((size_t)u.pn * 256 * 1024 + h * 256) * 2; } };
struct MapSQ { const char* h1; const char* btqk; __device__ __forceinline__ void operator()(Unit& u) const {
        u.a = h1 + (size_t)u.pm * 256 * 1024 * 2; u.b = btqk + (size_t)(batch_of_tile(u.pm) * 4 + u.pn) * 256 * 1024 * 2; } };
struct MapVW { const char* wxo; const char* vn; __device__ __forceinline__ void operator()(Unit& u) const {
        const int b = u.pm >> 2, h = u.pm & 3; u.a = wxo + ((size_t)u.pn * 256 * 1024 + h * 256) * 2; u.b = vn + ((size_t)b * 256 * 1024 + h * 256) * 2; } };
struct MapPVW { const char* P; const char* btvw; __device__ __forceinline__ void operator()(Unit& u) const {
        u.a = P + (size_t)u.pm * 256 * 1024 * 2; u.b = btvw + ((size_t)batch_of_tile(u.pm) * 1024 + u.pn * 256) * 1024 * 2; } };
struct MapS { const char* q; const char* kk; __device__ __forceinline__ void operator()(Unit& u) const {
        u.a = q + ((size_t)u.pm * 256 * 1024 + u.pn * 256) * 2; u.b = kk + ((size_t)batch_of_tile(u.pm) * 256 * 1024 + u.pn * 256) * 2; } };
struct MapPV { const char* P; const char* vt; __device__ __forceinline__ void operator()(Unit& u) const {
        u.a = P + ((size_t)u.pm * 256 * 1024 + u.pn * 256) * 2; u.b = vt + ((size_t)batch_of_tile(u.pm) * 1024 + u.pn * 256) * 256 * 2; } };

__device__ __forceinline__ void cpow_abar(float are, float aim, float dt, int e, float& pr, float& pi) {
    const float mag = expf(are * dt * (float)e);
    double rev = (double)aim * (double)dt * (double)e * 0.15915494309189535; rev -= floor(rev); if (rev > 0.5) rev -= 1.0;
    const float ang = (float)rev * 6.283185307179586f;
    pr = mag * __cosf(ang); pi = mag * __sinf(ang);
}
__device__ __forceinline__ void bbar_coef(float are, float aim, float dt, float& cr, float& ci) {
    const float x = are * dt;
    double rev = (double)aim * (double)dt * 0.15915494309189535; rev -= floor(rev); if (rev > 0.5) rev -= 1.0;
    const float y = (float)rev * 6.283185307179586f;
    const float ex1 = expm1f(x), cy = __cosf(y), sy = __sinf(y), sh = __sinf(0.5f * y);
    const float nr = ex1 * cy - 2.0f * sh * sh, ni = (ex1 + 1.0f) * sy;
    const float den = 1.0f / (are * are + aim * aim);
    cr = (nr * are + ni * aim) * den; ci = (ni * are - nr * aim) * den;
}

__device__ __forceinline__ void transpose_item(const float* W, int ldn, int K, bf16_t* WT, int srccol0, int dstrow0, int k0, const float* gk, float s, LAS float* scr, int lane) {
#pragma unroll 8
    for (int i = 0; i < 32; ++i) { const int kk = 2 * i + (lane >> 5); const float g = gk ? gk[k0 + kk] * s : s;
        scr[kk * 33 + (lane & 31)] = W[(size_t)(k0 + kk) * ldn + srccol0 + (lane & 31)] * g; }
    asm volatile("s_waitcnt lgkmcnt(0)" ::: "memory");
    const int c = lane & 7;
#pragma unroll
    for (int j = 0; j < 4; ++j) { const int n = (lane >> 3) + 8 * j; const LAS float* sp = scr + (8 * c) * 33 + n;
        u32x4 o; o.x = cvt_pk_bf16(sp[0 * 33], sp[1 * 33]); o.y = cvt_pk_bf16(sp[2 * 33], sp[3 * 33]); o.z = cvt_pk_bf16(sp[4 * 33], sp[5 * 33]); o.w = cvt_pk_bf16(sp[6 * 33], sp[7 * 33]);
        *(u32x4*)(WT + (size_t)(dstrow0 + n) * K + k0 + 8 * c) = o; }
    asm volatile("s_waitcnt lgkmcnt(0)" ::: "memory");
}

__device__ __forceinline__ void rows2_to_bf16(const float* xrow0, const float* xrow1, bf16_t* orow0, bf16_t* orow1, float* rinv0, float* rinv1, int lane) {
    const f32x4* xa = (const f32x4*)xrow0 + lane; const f32x4* xb = (const f32x4*)xrow1 + lane;
    f32x4 va[4], vb[4]; float sa = 0.f, sb = 0.f;
#pragma unroll
    for (int j = 0; j < 4; ++j) { va[j] = xa[64 * j]; vb[j] = xb[64 * j]; }
#pragma unroll
    for (int j = 0; j < 4; ++j) { sa += (va[j][0] * va[j][0] + va[j][1] * va[j][1]) + (va[j][2] * va[j][2] + va[j][3] * va[j][3]);
                                  sb += (vb[j][0] * vb[j][0] + vb[j][1] * vb[j][1]) + (vb[j][2] * vb[j][2] + vb[j][3] * vb[j][3]); }
    sa = wave_sum(sa); sb = wave_sum(sb);
    u32x2* oa = (u32x2*)orow0 + lane; u32x2* ob = (u32x2*)orow1 + lane;
#pragma unroll
    for (int j = 0; j < 4; ++j) { u32x2 w; w.x = cvt_pk_bf16(va[j][0], va[j][1]); w.y = cvt_pk_bf16(va[j][2], va[j][3]); oa[64 * j] = w;
                                  u32x2 y; y.x = cvt_pk_bf16(vb[j][0], vb[j][1]); y.y = cvt_pk_bf16(vb[j][2], vb[j][3]); ob[64 * j] = y; }
    if (lane == 0) { *rinv0 = rsqrtf(sa * (1.0f / 1024.0f) + EPS); *rinv1 = rsqrtf(sb * (1.0f / 1024.0f) + EPS); }
}

__device__ __forceinline__ void phase0(const Params& p, LAS unsigned char* lds, const int w0) {
    unsigned char* ws = p.ws;
    const int tid = fresh_tid(w0), wave = tid >> 6, lane = tid & 63, G = gridDim.x;
    const int gw = blockIdx.x * 8 + wave, NGW = G * 8;
    LAS float* scr = (LAS float*)(lds + wave * 16384);
    constexpr int I0 = 16 * 128, I5 = 16 * 64, I6 = 16 * 32;
    for (int it = gw; it < I0 + I5 + I6; it += NGW) {
        int r = it;
        if (r < I0) { const int kb = r / 128, nb = r % 128, n0 = nb * 32, t = n0 >> 8, w = n0 & 255; int src;
            if (t < 2) src = n0; else if (t < 6) src = (w < 128 ? 512 + (t - 2) * 128 + w : 1536 + (t - 2) * 128 + (w - 128)); else if (t < 8) src = 1024 + (t - 6) * 256 + w; else src = 2048 + (t - 8) * 256 + w;
            transpose_item(p.in[5], 4096, 1024, (bf16_t*)(ws + W_IN), src, n0, kb * 64, p.in[4], 1.0f, scr, lane); continue; } r -= I0;
        if (r < I5) { const int kb = r / 64, nb = r % 64; transpose_item(p.in[23], 2048, 1024, (bf16_t*)(ws + W_KV), nb * 32, nb * 32, kb * 64, p.in[21], 1.0f, scr, lane); continue; } r -= I5;
        { const int kb = r / 32, nb = r % 32; transpose_item(p.in[24], 1024, 1024, (bf16_t*)(ws + W_XO), nb * 32, nb * 32, kb * 64, nullptr, 1.0f, scr, lane); }
    }
    for (int row = 2 * gw; row < M; row += 2 * NGW) {
        const float* xr = row < MPROMPT ? p.in[0] + (size_t)row * D : p.in[1] + (size_t)(row - MPROMPT) * D;
        rows2_to_bf16(xr, xr + D, (bf16_t*)(ws + SLOT_A) + (size_t)row * D, (bf16_t*)(ws + SLOT_A) + (size_t)(row + 1) * D, (float*)(ws + RINV0P) + (size_t)(row >> 1) * 32, (float*)(ws + RINV0P) + (size_t)(row >> 1) * 32 + 1, lane);
    }
    for (int row = 2 * gw; row < MEMR; row += 2 * NGW) {
        const float* xr = row < 2048 ? p.in[2] + (size_t)row * D : p.in[3] + (size_t)(row - 2048) * D;
        rows2_to_bf16(xr, xr + D, (bf16_t*)(ws + MBUF) + (size_t)row * D, (bf16_t*)(ws + MBUF) + (size_t)(row + 1) * D, (float*)(ws + RINVMP) + (size_t)(row >> 1) * 32, (float*)(ws + RINVMP) + (size_t)(row >> 1) * 32 + 1, lane);
    }
    const float* a_re = p.in[7]; const float* a_im = p.in[8]; const float* log_dt = p.in[9];
    const float* b_re = p.in[10]; const float* b_im = p.in[11]; const float* c_re = p.in[12]; const float* c_im = p.in[13];
    const int gt = blockIdx.x * 512 + tid, NT = G * 512;
    for (int idx = gt; idx < 2 * 32 * 32 * 16; idx += NT) {
        const int pp = idx & 15, m = (idx >> 4) & 31, g = (idx >> 9) & 31, d = idx >> 14, dg = d * 32 + g;
        const float dt = expf(log_dt[dg]);
        float kq[16];
#pragma unroll
        for (int q = 0; q < 16; ++q) kq[q] = 0.f;
        for (int s = 0; s < 64; ++s) {
            const float are = a_re[dg * 64 + s], aim = a_im[dg * 64 + s];
            float pr, pi, cr, ci; cpow_abar(are, aim, dt, m, pr, pi); bbar_coef(are, aim, dt, cr, ci);
            const float tr0 = pr * cr - pi * ci, ti0 = pr * ci + pi * cr;
            const float cre = c_re[(dg * 16 + pp) * 64 + s], cim = c_im[(dg * 16 + pp) * 64 + s];
            const float tr = tr0 * cre - ti0 * cim, ti = tr0 * cim + ti0 * cre;
            const f32x4* br = (const f32x4*)(b_re + (size_t)(dg * 64 + s) * 16); const f32x4* bi = (const f32x4*)(b_im + (size_t)(dg * 64 + s) * 16);
#pragma unroll
            for (int q4 = 0; q4 < 4; ++q4) { const f32x4 r4 = br[q4], i4 = bi[q4];
#pragma unroll
                for (int e = 0; e < 4; ++e) kq[q4 * 4 + e] += tr * r4[e] - ti * i4[e]; }
        }
        f32x4* o = (f32x4*)((float*)(ws + KTAB) + (size_t)idx * 16);
#pragma unroll
        for (int q4 = 0; q4 < 4; ++q4) o[q4] = (f32x4){kq[q4 * 4], kq[q4 * 4 + 1], kq[q4 * 4 + 2], kq[q4 * 4 + 3]};
    }
    for (int idx = gt; idx < 1024 * 128; idx += NT) {
        const int kk = idx >> 7, n8 = (idx & 127) * 8; const float g = p.in[20][kk] * 0.0625f;
        const f32x4 a = *(const f32x4*)(p.in[22] + (size_t)kk * 1024 + n8), b = *(const f32x4*)(p.in[22] + (size_t)kk * 1024 + n8 + 4);
        *(u32x4*)((bf16_t*)(ws + WQN) + (size_t)kk * 1024 + n8) = pack8(a * g, b * g);
    }
}

__device__ __forceinline__ void phase1(const Params& p, LAS unsigned char* lds, const int w0) {
    unsigned char* ws = p.ws; const int tid = fresh_tid(w0), G = gridDim.x;
    { EpiIn E{(bf16_t*)(ws + SLOT_B), (bf16_t*)(ws + SLOT_C), (bf16_t*)(ws + SLOT_C + HALF_SLOT), (bf16_t*)p.out, (const float*)(ws + RINV0P), p.in[6]};
      MapPlain mp{(const char*)(ws + SLOT_A), (const char*)(ws + W_IN), (size_t)256 * 1024 * 2, (size_t)256 * 1024 * 2};
      gemm_phase(lds, M / 256, 16, 2048, 2048, 1024, mp, E, blockIdx.x, G, w0); }
    { EpiKV E{(bf16_t*)(ws + KK), (bf16_t*)(ws + VT), (const float*)(ws + RINVMP)};
      MapPlain mp{(const char*)(ws + MBUF), (const char*)(ws + W_KV), (size_t)256 * 1024 * 2, (size_t)256 * 1024 * 2};
      gemm_phase(lds, MEMR / 256, 8, 2048, 2048, 1024, mp, E, G - 1 - blockIdx.x, G, w0); }
    if ((int)blockIdx.x < G - 96) {
      const int wave = tid >> 6, lane = tid & 63, ND = G - 96;
      const int gw = blockIdx.x * 8 + wave, NGW = ND * 8, gt = blockIdx.x * 512 + tid, NT = ND * 512;
      LAS float* scr = (LAS float*)(lds + wave * 16384);
      constexpr int I1 = 8 * 64, I2 = 8 * 32, I3 = 16 * 32, I7 = 16 * 176, I8 = 44 * 32;
      for (int it = gw; it < I1 + I2 + I3 + I7 + I8; it += NGW) {
        int r = it;
        if (r < I1) { const int kb = r / 64, nb = r % 64, n0 = nb * 32, t = n0 >> 8, w = n0 & 255;
            transpose_item(w < 128 ? p.in[15] : p.in[16], 1024, 512, (bf16_t*)(ws + W_GLU), t * 128 + (w & 127), n0, kb * 64, nullptr, 1.0f, scr, lane); continue; } r -= I1;
        if (r < I2) { const int kb = r / 32, nb = r % 32; transpose_item(p.in[18], 1024, 512, (bf16_t*)(ws + W_CONV), nb * 32, nb * 32, kb * 64, nullptr, 1.0f, scr, lane); continue; } r -= I2;
        if (r < I3) { const int kb = r / 32, nb = r % 32; transpose_item(p.in[19], 1024, 1024, (bf16_t*)(ws + W_O), nb * 32, nb * 32, kb * 64, nullptr, 1.0f, scr, lane); continue; } r -= I3;
        if (r < I7) { const int kb = r / 176, nb = r % 176, n0 = nb * 32, t = n0 >> 8, w = n0 & 255;
            transpose_item(p.in[26], 5632, 1024, (bf16_t*)(ws + W_GU), w < 128 ? t * 128 + w : DFF + t * 128 + (w - 128), n0, kb * 64, p.in[25], 1.0f, scr, lane); continue; } r -= I7;
        { const int kb = r / 32, nb = r % 32; transpose_item(p.in[27], 1024, DFF, (bf16_t*)(ws + W_DN), nb * 32, nb * 32, kb * 64, nullptr, 1.0f, scr, lane); }
      }
      const float* a_re = p.in[7]; const float* a_im = p.in[8]; const float* log_dt = p.in[9];
      const float* b_re = p.in[10]; const float* b_im = p.in[11]; const float* c_re = p.in[12]; const float* c_im = p.in[13];
    for (int idx = gt; idx < 32 * 256 * 32; idx += NT) {
        const int j = idx & 31, n = (idx >> 5) & 255, g = idx >> 13, d = n >> 7, ri = (n >> 6) & 1, s = n & 63, dg = d * 32 + g;
        const float dt = expf(log_dt[dg]), are = a_re[dg * 64 + s], aim = a_im[dg * 64 + s];
        float pr, pi, cr, ci; cpow_abar(are, aim, dt, d == 0 ? (LC - 1 - j) : j, pr, pi); bbar_coef(are, aim, dt, cr, ci);
        const float tr = pr * cr - pi * ci, ti = pr * ci + pi * cr;
        const f32x4* br = (const f32x4*)(b_re + (size_t)(dg * 64 + s) * 16); const f32x4* bi = (const f32x4*)(b_im + (size_t)(dg * 64 + s) * 16);
        f32x4 v[4];
#pragma unroll
        for (int q4 = 0; q4 < 4; ++q4) { const f32x4 r4 = br[q4], i4 = bi[q4]; v[q4] = ri == 0 ? (r4 * tr - i4 * ti) : (i4 * tr + r4 * ti); }
        u32x4* o = (u32x4*)((bf16_t*)(ws + BT_STATE) + ((size_t)(g * 256 + n) * 512 + j * 16));
        o[0] = pack8(v[0], v[1]); o[1] = pack8(v[2], v[3]);
    }
    for (int idx = gt; idx < 32 * 32 * 2 * 64; idx += NT) {
        const int s = idx & 63, d = (idx >> 6) & 1, j = (idx >> 7) & 31, g = idx >> 12, dg = d * 32 + g;
        const float dt = expf(log_dt[dg]), are = a_re[dg * 64 + s], aim = a_im[dg * 64 + s];
        float pr, pi; cpow_abar(are, aim, dt, d == 0 ? (j + 1) : (LC - j), pr, pi);
        bf16_t* o = (bf16_t*)(ws + BT_Y) + ((size_t)(g * 512 + j * 16) * KCAT + d * 128 + s);
#pragma unroll 4
        for (int pp = 0; pp < 16; ++pp) { const float cre = c_re[(dg * 16 + pp) * 64 + s], cim = c_im[(dg * 16 + pp) * 64 + s];
            const unsigned w = cvt_pk_bf16(cre * pr - cim * pi, -(cre * pi + cim * pr));
            o[(size_t)pp * KCAT] = (bf16_t)(w & 0xffff); o[(size_t)pp * KCAT + 64] = (bf16_t)(w >> 16); }
    }
    { const float* ktab = (const float*)(ws + KTAB); const float* dsk = p.in[14];
      for (int idx = gt; idx < 32 * 32 * 16 * 32; idx += NT) {
        const int i = idx & 31, pp = (idx >> 5) & 15, j = (idx >> 9) & 31, g = idx >> 14;
        f32x4 v[4];
#pragma unroll
        for (int q4 = 0; q4 < 4; ++q4) v[q4] = (f32x4){0.f, 0.f, 0.f, 0.f};
        if (i <= j) { const f32x4* k = (const f32x4*)(ktab + ((size_t)((0 * 32 + g) * 32 + (j - i)) * 256 + pp * 16));
#pragma unroll
            for (int q4 = 0; q4 < 4; ++q4) v[q4] += k[q4]; }
        if (i >= j) { const f32x4* k = (const f32x4*)(ktab + ((size_t)((1 * 32 + g) * 32 + (i - j)) * 256 + pp * 16));
#pragma unroll
            for (int q4 = 0; q4 < 4; ++q4) v[q4] += k[q4]; }
        if (i == j) { const float dv = dsk[g * 16 + pp];
#pragma unroll
            for (int q4 = 0; q4 < 4; ++q4)
#pragma unroll
                for (int e = 0; e < 4; ++e) if (q4 * 4 + e == pp) v[q4][e] += dv; }
        u32x4* o = (u32x4*)((bf16_t*)(ws + BT_Y) + ((size_t)(g * 512 + j * 16 + pp) * KCAT + 256 + i * 16));
        o[0] = pack8(v[0], v[1]); o[1] = pack8(v[2], v[3]);
      } }
    }
}

__device__ __forceinline__ void phase2(const Params& p, LAS unsigned char* lds, const int w0) {
    unsigned char* ws = p.ws; const int tid = fresh_tid(w0), G = gridDim.x;
    { EpiState E{(float*)(ws + SLOT_D)};
      MapState mp{(const char*)(ws + SLOT_B), (const char*)(ws + BT_STATE)};
      gemm_phase(lds, (M / LC) / 256, NG, NG * KCAT * 2, 512 * 2, 512, mp, E, blockIdx.x, G, w0); }
    { EpiPlain E{(bf16_t*)(ws + BT_QK)};
      MapQK mp{(const char*)(ws + KK), (const char*)(ws + WQN)};
      gemm_phase(lds, 48, 4, 2048, 2048, 256, mp, E, G - 1 - blockIdx.x, G, w0); }
    { EpiVW E{(bf16_t*)(ws + BT_VW)};
      MapVW mp{(const char*)(ws + W_XO), (const char*)(ws + VT)};
      gemm_phase(lds, 48, 4, 2048, 2048, 256, mp, E, G - 1 - blockIdx.x, G, w0); }
    { const bf16_t* z = (const bf16_t*)(ws + SLOT_C); const bf16_t* gb = (const bf16_t*)(ws + SLOT_C + HALF_SLOT); bf16_t* cz = (bf16_t*)(ws + SLOT_D + HALF_SLOT);
      const float* cw = p.in[17];
      for (int idx = blockIdx.x * 512 + tid; idx < M * 64; idx += G * 512) {
        const int c8 = (idx & 63) * 8, t = idx >> 6;
        const int pos = t < MPROMPT ? (t & 8191) : ((t - MPROMPT) & 4095), L = t < MPROMPT ? 8192 : 4096;
        f32x4 w0a = *(const f32x4*)(cw + c8), w0b = *(const f32x4*)(cw + c8 + 4), w1a = *(const f32x4*)(cw + 512 + c8), w1b = *(const f32x4*)(cw + 512 + c8 + 4), w2a = *(const f32x4*)(cw + 1024 + c8), w2b = *(const f32x4*)(cw + 1024 + c8 + 4);
        f32x4 z0, z1, a0, a1; unpack8(*(const u32x4*)(z + (size_t)t * 512 + c8), z0, z1);
        a0 = w1a * z0; a1 = w1b * z1;
        if (pos > 0) { unpack8(*(const u32x4*)(z + (size_t)(t - 1) * 512 + c8), z0, z1); a0 += w0a * z0; a1 += w0b * z1; }
        if (pos < L - 1) { unpack8(*(const u32x4*)(z + (size_t)(t + 1) * 512 + c8), z0, z1); a0 += w2a * z0; a1 += w2b * z1; }
        unpack8(*(const u32x4*)(gb + (size_t)t * 512 + c8), z0, z1);
        *(u32x4*)(cz + (size_t)t * 512 + c8) = pack8(a0 * z0, a1 * z1);
      } }
}

__device__ __forceinline__ void phase3(const Params& p, LAS unsigned char* lds, const int w0) {
    unsigned char* ws = p.ws; const int tid = fresh_tid(w0), wave = tid >> 6, lane = tid & 63, G = gridDim.x;
    { const float* S = (const float*)(ws + SLOT_D); bf16_t* acat = (bf16_t*)(ws + SLOT_B);
      const float* a_re = p.in[7]; const float* a_im = p.in[8]; const float* log_dt = p.in[9];
      for (int item = blockIdx.x + G * wave; item < 12 * 32 * 2; item += G * 8) {
        const int d = item & 1, g = (item >> 1) & 31, b = item >> 6, dg = d * 32 + g;
        const int cr0 = b < 8 ? b * 256 : 2048 + (b - 8) * 128, nch = b < 8 ? 256 : 128;
        const float dt = expf(log_dt[dg]);
        float ar, ai; cpow_abar(a_re[dg * 64 + lane], a_im[dg * 64 + lane], dt, LC, ar, ai);
        float hr = 0.f, hi = 0.f;
        const int step = d == 0 ? 1 : -1; int c = d == 0 ? cr0 : cr0 + nch - 1;
        float sr[8], si[8];
#pragma unroll
        for (int e = 0; e < 8; ++e) { const float* sp = S + ((size_t)(c + e * step) * NG + g) * 256 + d * 128 + lane; sr[e] = sp[0]; si[e] = sp[64]; }
        for (int blk = 0; blk < nch; blk += 8) {
            float nr[8], ni[8];
            const bool more = blk + 8 < nch;
#pragma unroll
            for (int e = 0; e < 8; ++e) { const int cc = more ? c + (8 + e) * step : c; const float* sp = S + ((size_t)cc * NG + g) * 256 + d * 128 + lane; nr[e] = sp[0]; ni[e] = sp[64]; }
#pragma unroll
            for (int e = 0; e < 8; ++e) {
                bf16_t* hp = acat + ((size_t)(c + e * step) * NG + g) * KCAT + d * 128 + lane;
                const unsigned w = cvt_pk_bf16(hr, hi); hp[0] = (bf16_t)(w & 0xffff); hp[64] = (bf16_t)(w >> 16);
                const float t = ar * hr - ai * hi + sr[e]; hi = ar * hi + ai * hr + si[e]; hr = t;
            }
#pragma unroll
            for (int e = 0; e < 8; ++e) { sr[e] = nr[e]; si[e] = ni[e]; }
            c += 8 * step;
        }
      } }
    __syncthreads();
    { EpiConv E{(bf16_t*)(ws + SLOT_E), (const bf16_t*)p.out};
      MapPlain mp{(const char*)(ws + SLOT_D + HALF_SLOT), (const char*)(ws + W_CONV), (size_t)256 * 512 * 2, (size_t)256 * 512 * 2};
      gemm_phase(lds, M / 256, 4, 1024, 1024, 512, mp, E, blockIdx.x, G, w0); }
}

__device__ __forceinline__ void phase4(const Params& p, LAS unsigned char* lds, const int w0) {
    unsigned char* ws = p.ws;
    EpiY E{(bf16_t*)(ws + SLOT_C)};
    MapY mp{(const char*)(ws + SLOT_B), (const char*)(ws + BT_Y)};
    gemm_phase(lds, (M / LC) / 256, NG * 2, NG * KCAT * 2, KCAT * 2, KCAT, mp, E, blockIdx.x, gridDim.x, w0);
}
__device__ __forceinline__ void phase5(const Params& p, LAS unsigned char* lds, const int w0) {
    unsigned char* ws = p.ws;
    EpiGlu E{(const bf16_t*)(ws + SLOT_E), (const bf16_t*)p.out, (bf16_t*)(ws + SLOT_D)};
    MapPlain mp{(const char*)(ws + SLOT_C), (const char*)(ws + W_GLU), (size_t)256 * 32, (size_t)256 * 512 * 2};
    gemm_phase(lds, M / 256, 8, M * 32, 1024, 512, mp, E, blockIdx.x, gridDim.x, w0, 1);
}
__device__ __forceinline__ void phase6(const Params& p, LAS unsigned char* lds, const int w0) {
    unsigned char* ws = p.ws;
    EpiRes E{(const bf16_t*)(ws + SLOT_A), (bf16_t*)(ws + SLOT_C), (float*)(ws + SSQ1), (LAS float*)(lds + STAGE_BYTES)};
    MapPlain mp{(const char*)(ws + SLOT_D), (const char*)(ws + W_O), (size_t)256 * 1024 * 2, (size_t)256 * 1024 * 2};
    gemm_phase(lds, M / 256, 4, 2048, 2048, 1024, mp, E, blockIdx.x, gridDim.x, w0);
}
__device__ __forceinline__ void phase7(const Params& p, LAS unsigned char* lds, const int w0) {
    unsigned char* ws = p.ws;
    EpiSoftmaxR E{(bf16_t*)(ws + SLOT_D), (LAS float*)(lds + STAGE_BYTES), (const float*)(ws + SSQ1)};
    MapSQ mp{(const char*)(ws + SLOT_C), (const char*)(ws + BT_QK)};
    gemm_phase(lds, M / 256, 4, 2048, 2048, 1024, mp, E, blockIdx.x, gridDim.x, w0);
}
__device__ __forceinline__ void phase9(const Params& p, LAS unsigned char* lds, const int w0) {
    unsigned char* ws = p.ws;
    EpiRes E{(const bf16_t*)(ws + SLOT_C), (bf16_t*)(ws + SLOT_A), (float*)(ws + SSQ2), (LAS float*)(lds + STAGE_BYTES)};
    MapPVW mp{(const char*)(ws + SLOT_D), (const char*)(ws + BT_VW)};
    gemm_phase(lds, M / 256, 4, 2048, 2048, 1024, mp, E, blockIdx.x, gridDim.x, w0);
}
__device__ __forceinline__ void phase11(const Params& p, LAS unsigned char* lds, const int w0) {
    unsigned char* ws = p.ws;
    EpiGU E{(bf16_t*)(ws + SLOT_B), (const float*)(ws + SSQ2)};
    MapPlain mp{(const char*)(ws + SLOT_A), (const char*)(ws + W_GU), (size_t)256 * 1024 * 2, (size_t)256 * 1024 * 2};
    gemm_phase(lds, M / 256, 22, 2048, 2048, 1024, mp, E, blockIdx.x, gridDim.x, w0);
}
__device__ __forceinline__ void phase12(const Params& p, LAS unsigned char* lds, const int w0) {
    unsigned char* ws = p.ws;
    EpiDown E{(const bf16_t*)(ws + SLOT_A), (bf16_t*)(ws + SLOT_E), (float*)(ws + SSQ3), (LAS float*)(lds + STAGE_BYTES)};
    MapPlain mp{(const char*)(ws + SLOT_B), (const char*)(ws + W_DN), (size_t)256 * DFF * 2, (size_t)256 * DFF * 2};
    gemm_phase(lds, M / 256, 4, DFF * 2, DFF * 2, DFF, mp, E, blockIdx.x, gridDim.x, w0);
}
__device__ __forceinline__ void phase13(const Params& p, const int w0) {
    unsigned char* ws = p.ws; const int tid = fresh_tid(w0), wave = tid >> 6, lane = tid & 63;
    const float* gf = p.in[28]; const float* ssq = (const float*)(ws + SSQ3); const bf16_t* h3 = (const bf16_t*)(ws + SLOT_E);
    f32x4 ga[2], gb2[2];
#pragma unroll
    for (int j = 0; j < 2; ++j) { ga[j] = *(const f32x4*)(gf + j * 512 + lane * 8); gb2[j] = *(const f32x4*)(gf + j * 512 + lane * 8 + 4); }
    for (int row = 2 * (blockIdx.x * 8 + wave); row < M; row += 2 * gridDim.x * 8) {
        u32x4 w0a[2], w1a[2];
#pragma unroll
        for (int j = 0; j < 2; ++j) { w0a[j] = *(const u32x4*)(h3 + (size_t)row * D + j * 512 + lane * 8); w1a[j] = *(const u32x4*)(h3 + (size_t)(row + 1) * D + j * 512 + lane * 8); }
        const float r0 = rinv_from_ssq4(ssq, row), r1 = rinv_from_ssq4(ssq, row + 1);
#pragma unroll
        for (int j = 0; j < 2; ++j) { f32x4 a, b; unpack8(w0a[j], a, b);
            float* o = p.out + (size_t)row * D + j * 512 + lane * 8; *(f32x4*)o = a * r0 * ga[j]; *(f32x4*)(o + 4) = b * r0 * gb2[j];
            unpack8(w1a[j], a, b);
            float* o1 = p.out + (size_t)(row + 1) * D + j * 512 + lane * 8; *(f32x4*)o1 = a * r1 * ga[j]; *(f32x4*)(o1 + 4) = b * r1 * gb2[j]; }
    }
}

template <bool COOP>
__global__ void __launch_bounds__(512, 2) fwd_kernel(Params p) {
    extern __shared__ __attribute__((aligned(16))) unsigned char lds_raw[];
    LAS unsigned char* lds = (LAS unsigned char*)lds_raw;
    const int w0 = __builtin_amdgcn_readfirstlane((int)threadIdx.x >> 6);
    unsigned* const bar = (unsigned*)(p.ws + BARW);
    unsigned* const bctr = bar + HB_CTR;
    volatile LAS unsigned* const basew = (volatile LAS unsigned*)(lds + STAGE_BYTES + 8192);
    if constexpr (COOP) {
        if (w0 == 0 && __builtin_amdgcn_mbcnt_hi(~0u, __builtin_amdgcn_mbcnt_lo(~0u, 0u)) == 0u) {
            const unsigned x = hb_xcc();
            basew[0] = xb_read(bctr); basew[3] = xb_read(&bar[HB_XSUB(x)]); basew[4] = xb_read(&bar[HB_XGEN(x)]); basew[5] = xb_read(&bar[HB_TOP]); basew[6] = xb_read(&bar[HB_TOPGEN]);
            for (unsigned j = 0; j < 16; ++j) basew[8 + j] = xb_read(&bar[HB_XCNT(j)]);
        }
        __syncthreads();
    }
    unsigned seam = 0u;
#define RUN_PHASE(k, call) if (p.ph_lo <= (k) && (k) < p.ph_hi) { call; if constexpr (COOP) { if ((k) + 1 < p.ph_hi) { \
        if ((k) == 0) { cg::this_grid().sync(); if (w0 == 0 && __builtin_amdgcn_mbcnt_hi(~0u, __builtin_amdgcn_mbcnt_lo(~0u, 0u)) == 0u) (void)xb_add(&bar[HB_XCNT(hb_xcc())], 1u); } \
        else if (seam == 0u) { ++seam; ctr_barrier(bctr, basew, 1u, w0); \
            if (w0 == 0 && __builtin_amdgcn_mbcnt_hi(~0u, __builtin_amdgcn_mbcnt_lo(~0u, 0u)) == 0u) { const unsigned x = hb_xcc(); unsigned nx = 0u, nloc = 1u; \
                for (unsigned j = 0; j < 16; ++j) { const unsigned n = xb_read(&bar[HB_XCNT(j)]) - basew[8 + j]; nx += n ? 1u : 0u; if (j == x) nloc = n; } \
                basew[1] = nloc; basew[2] = nx ? nx : 1u; } \
            __syncthreads(); } \
        else { hier_barrier(bar, basew, seam, w0); ++seam; } } } }
    RUN_PHASE(0, phase0(p, lds, w0))
    RUN_PHASE(1, phase1(p, lds, w0))
    RUN_PHASE(2, phase2(p, lds, w0))
    RUN_PHASE(3, phase3(p, lds, w0))
    RUN_PHASE(4, phase4(p, lds, w0))
    RUN_PHASE(5, phase5(p, lds, w0))
    RUN_PHASE(6, phase6(p, lds, w0))
    RUN_PHASE(7, phase7(p, lds, w0))
    RUN_PHASE(9, phase9(p, lds, w0))
    RUN_PHASE(11, phase11(p, lds, w0))
    RUN_PHASE(12, phase12(p, lds, w0))
    RUN_PHASE(13, phase13(p, w0))
#undef RUN_PHASE
}

extern "C" void kernel_launch(void* const* d_in, const int* in_sizes, int n_in, void* d_out, int out_size, void* d_ws, size_t ws_size, hipStream_t stream) {
    static int grid = 0;
    if (grid == 0) {
        if (n_in != 29 || out_size != M * D || ws_size < WS_END) { fprintf(stderr, "kernel_launch: unexpected shapes (n_in %d out %d ws %zu need %zu)\n", n_in, out_size, ws_size, (size_t)WS_END); grid = -1; return; }
        int dev = 0, cus = 0, per_cu = 0;
        (void)hipGetDevice(&dev); (void)hipDeviceGetAttribute(&cus, hipDeviceAttributeMultiprocessorCount, dev);
        (void)hipFuncSetAttribute((const void*)fwd_kernel<N_LAUNCH_MODE == 1>, hipFuncAttributeMaxDynamicSharedMemorySize, LDS_BYTES);
        (void)hipOccupancyMaxActiveBlocksPerMultiprocessor(&per_cu, (const void*)fwd_kernel<N_LAUNCH_MODE == 1>, 512, LDS_BYTES);
        if (per_cu < 1) per_cu = 1;
        grid = cus * 1;
        (void)hipGetLastError();
    }
    if (grid < 0) return;
    Params p{};
    for (int i = 0; i < 29; ++i) p.in[i] = (const float*)d_in[i];
    p.out = (float*)d_out; p.ws = (unsigned char*)d_ws;
#if N_LAUNCH_MODE == 1
    p.ph_lo = 0; p.ph_hi = NPHASE;
    void* args[] = {&p};
    hipError_t e = hipLaunchCooperativeKernel((const void*)fwd_kernel<true>, dim3(grid), dim3(512), args, LDS_BYTES, stream);
    if (e != hipSuccess) fprintf(stderr, "cooperative launch failed: %s (grid %d)\n", hipGetErrorString(e), grid);
#else
    for (int ph = 0; ph < NPHASE; ++ph) {
        p.ph_lo = ph; p.ph_hi = ph + 1;
        hipLaunchKernelGGL(fwd_kernel<false>, dim3(grid), dim3(512), LDS_BYTES, stream, p);
    }
#endif
}
```

```cpp
#include <hip/hip_runtime.h>
#include <hip/hip_cooperative_groups.h>
#include <cstdio>
namespace cg = cooperative_groups;

#ifndef N_LAUNCH_MODE
#define N_LAUNCH_MODE 1
#endif

#define LAS __attribute__((address_space(3)))
typedef unsigned short bf16_t;
typedef short bf16x8 __attribute__((ext_vector_type(8)));
typedef float f32x4 __attribute__((ext_vector_type(4)));
typedef unsigned u32x4 __attribute__((ext_vector_type(4)));
typedef unsigned u32x2 __attribute__((ext_vector_type(2)));

constexpr int D = 1024, M = 81920, MPROMPT = 65536, MEMR = 3072, DFF = 2816;
constexpr int LC = 32, KCAT = 256 + 16 * LC, NG = 32;
constexpr float EPS = 1e-6f;
constexpr int NPHASE = 14;

constexpr size_t MB1 = 1048576;
constexpr size_t W_IN = 0;
constexpr size_t W_GLU = W_IN + 4096ull * 1024 * 2;
constexpr size_t W_CONV = W_GLU + 2048ull * 512 * 2;
constexpr size_t W_O = W_CONV + 1024ull * 512 * 2;
constexpr size_t W_Q = W_O + 1024ull * 1024 * 2;
constexpr size_t W_KV = W_Q + 1024ull * 1024 * 2;
constexpr size_t W_XO = W_KV + 2048ull * 1024 * 2;
constexpr size_t W_GU = W_XO + 1024ull * 1024 * 2;
constexpr size_t W_DN = W_GU + 5632ull * 1024 * 2;
constexpr size_t BT_STATE = W_DN + 1024ull * 2816 * 2;
constexpr size_t BT_Y = BT_STATE + 32ull * 256 * 512 * 2;
constexpr size_t KTAB = BT_Y + 32ull * 512 * 768 * 2;
constexpr size_t MBUF = KTAB + 2ull * 32 * 32 * 256 * 4;
constexpr size_t KK = MBUF + 3072ull * 1024 * 2;
constexpr size_t VT = KK + 3072ull * 1024 * 2;
constexpr size_t RINV0 = VT + 3072ull * 1024 * 2;
constexpr size_t RINVM = RINV0 + (size_t)M * 4;
constexpr size_t SSQ1 = RINVM + 3072ull * 4;
constexpr size_t SSQ2 = SSQ1 + (size_t)M * 64;
constexpr size_t SSQ3 = SSQ2 + (size_t)M * 64;
constexpr size_t LPART = SSQ3 + (size_t)M * 64;
constexpr size_t RINV0P = LPART + (size_t)M * 64;
constexpr size_t RINVMP = RINV0P + (size_t)(M / 2) * 128;
constexpr size_t BARW = RINVMP + (size_t)(MEMR / 2) * 128;
constexpr size_t R0_END = BARW + 16384;
constexpr size_t SLOT = 160 * MB1;
constexpr size_t SLOT_A = 128 * MB1;
constexpr size_t SLOT_B = SLOT_A + SLOT;
constexpr size_t SLOT_C = SLOT_B + SLOT;
constexpr size_t SLOT_D = SLOT_C + SLOT;
constexpr size_t SLOT_E = SLOT_D + SLOT;
constexpr size_t WQN = SLOT_E + SLOT;
constexpr size_t BT_QK = WQN + 1024ull * 1024 * 2;
constexpr size_t BT_VW = BT_QK + 48ull * 256 * 1024 * 2;
constexpr size_t WS_END = BT_VW + 12ull * 1024 * 1024 * 2;
static_assert(R0_END <= SLOT_A, "region 0 overflow");
constexpr size_t HALF_SLOT = 80 * MB1;

constexpr int STAGE_BYTES = 131072;
constexpr int LDS_BYTES = STAGE_BYTES + 8192 + 256;

struct Params {
    const float* in[29];
    float* out;
    unsigned char* ws;
    int ph_lo, ph_hi;
};

__device__ __forceinline__ int fresh_tid(const int w0) { int t = w0 * 64 + (int)__builtin_amdgcn_mbcnt_hi(~0u, __builtin_amdgcn_mbcnt_lo(~0u, 0u)); asm volatile("" : "+v"(t)); return t; }
__device__ __forceinline__ unsigned cvt_pk_bf16(float lo, float hi) { unsigned r; asm("v_cvt_pk_bf16_f32 %0, %1, %2" : "=v"(r) : "v"(lo), "v"(hi)); return r; }
__device__ __forceinline__ float bf_lo(unsigned w) { return __uint_as_float(w << 16); }
__device__ __forceinline__ float bf_hi(unsigned w) { return __uint_as_float(w & 0xffff0000u); }
__device__ __forceinline__ void unpack8(const u32x4 w, f32x4& a, f32x4& b) {
    a = (f32x4){bf_lo(w.x), bf_hi(w.x), bf_lo(w.y), bf_hi(w.y)};
    b = (f32x4){bf_lo(w.z), bf_hi(w.z), bf_lo(w.w), bf_hi(w.w)};
}
__device__ __forceinline__ u32x4 pack8(const f32x4 a, const f32x4 b) {
    u32x4 w; w.x = cvt_pk_bf16(a[0], a[1]); w.y = cvt_pk_bf16(a[2], a[3]); w.z = cvt_pk_bf16(b[0], b[1]); w.w = cvt_pk_bf16(b[2], b[3]); return w;
}
__device__ __forceinline__ float sigmoidf_(float x) { return __builtin_amdgcn_rcpf(1.0f + __expf(-x)); }
__device__ __forceinline__ f32x4 sigmoid4(f32x4 x) { return (f32x4){sigmoidf_(x[0]), sigmoidf_(x[1]), sigmoidf_(x[2]), sigmoidf_(x[3])}; }
__device__ __forceinline__ float gelu_tanh(float x) { const float t = 1.5957691216057308f * (x + 0.044715f * x * x * x); return x * sigmoidf_(t); }
__device__ __forceinline__ f32x4 gelu4(f32x4 x) { return (f32x4){gelu_tanh(x[0]), gelu_tanh(x[1]), gelu_tanh(x[2]), gelu_tanh(x[3])}; }
__device__ __forceinline__ float wave_sum(float v) {
#pragma unroll
    for (int o = 1; o < 64; o <<= 1) v += __shfl_xor(v, o);
    return v;
}
__device__ __forceinline__ float rinv_from_ssq4(const float* ssq, int row) {
    const f32x4 s = (f32x4){ssq[row], ssq[M + row], ssq[2 * M + row], ssq[3 * M + row]};
    return rsqrtf(((s[0] + s[1]) + (s[2] + s[3])) * (1.0f / 1024.0f) + EPS);
}
__device__ __forceinline__ int batch_of_tile(int pm) { return pm < 256 ? (pm >> 5) : 8 + ((pm - 256) >> 4); }


__device__ __forceinline__ unsigned xb_add(unsigned* p, unsigned v) { return __hip_atomic_fetch_add(p, v, __ATOMIC_RELAXED, __HIP_MEMORY_SCOPE_AGENT); }
__device__ __forceinline__ unsigned xb_read(unsigned* p) { unsigned z = 0u; asm volatile("" : "+s"(z)); return __hip_atomic_fetch_add(p, z, __ATOMIC_RELAXED, __HIP_MEMORY_SCOPE_AGENT); }
#define HB_CTR      64
#define HB_XCNT(j)  (128  + 64 * (j))
#define HB_XSUB(j)  (1152 + 64 * (j))
#define HB_XGEN(j)  (2176 + 64 * (j))
#define HB_TOP      3200
#define HB_TOPGEN   3264
#define HB_WORDS    3328
__device__ __forceinline__ unsigned hb_xcc() { return (unsigned)__builtin_amdgcn_s_getreg((3 << 11) | 20) & 0xFu; }
__device__ __forceinline__ void hier_barrier(unsigned* bar, volatile LAS unsigned* lw, const unsigned r, const int w0) {
    asm volatile("s_waitcnt vmcnt(0) lgkmcnt(0)" ::: "memory");
    __syncthreads();
    if (w0 == 0 && __builtin_amdgcn_mbcnt_hi(~0u, __builtin_amdgcn_mbcnt_lo(~0u, 0u)) == 0u) {
        const unsigned x = hb_xcc(), nloc = lw[1], nx = lw[2];
        const unsigned old = xb_add(&bar[HB_XSUB(x)], 1u) - lw[3];
        unsigned sp = 0u;
        if (old + 1u == r * nloc) {
            __builtin_amdgcn_fence(__ATOMIC_RELEASE, "agent");
            asm volatile("s_waitcnt vmcnt(0)" ::: "memory");
            const unsigned og = xb_add(&bar[HB_TOP], 1u) - lw[5];
            if (og + 1u == r * nx) (void)xb_add(&bar[HB_TOPGEN], 1u);
            else while ((int)(xb_read(&bar[HB_TOPGEN]) - lw[6] - r) < 0) { __builtin_amdgcn_s_sleep(2); if (++sp > (1u << 24)) break; }
            __builtin_amdgcn_fence(__ATOMIC_ACQUIRE, "agent");
            (void)xb_add(&bar[HB_XGEN(x)], 1u);
            asm volatile("s_waitcnt vmcnt(0)" ::: "memory");
        } else {
            while ((int)(xb_read(&bar[HB_XGEN(x)]) - lw[4] - r) < 0) { __builtin_amdgcn_s_sleep(2); if (++sp > (1u << 24)) break; }
            __builtin_amdgcn_fence(__ATOMIC_ACQUIRE, "agent");
            asm volatile("s_waitcnt vmcnt(0)" ::: "memory");
        }
    }
    __syncthreads();
}
__device__ __forceinline__ void ctr_barrier(unsigned* ctr, volatile LAS unsigned* basew, const unsigned k, const int w0) {
    asm volatile("s_waitcnt vmcnt(0) lgkmcnt(0)" ::: "memory");
    __syncthreads();
    if (w0 == 0 && __builtin_amdgcn_mbcnt_hi(~0u, __builtin_amdgcn_mbcnt_lo(~0u, 0u)) == 0u) {
        __builtin_amdgcn_fence(__ATOMIC_RELEASE, "agent");
        asm volatile("s_waitcnt vmcnt(0)" ::: "memory");
        const unsigned target = basew[0] + k * gridDim.x;
        unsigned cur = xb_add(ctr, 1u) + 1u;
        unsigned sp = 0u;
        while ((int)(cur - target) < 0) { __builtin_amdgcn_s_sleep(20); cur = xb_read(ctr); if (++sp > (1u << 22)) break; }
        __builtin_amdgcn_fence(__ATOMIC_ACQUIRE, "agent");
        asm volatile("s_waitcnt vmcnt(0)" ::: "memory");
    }
    __syncthreads();
}

constexpr int BM = 256, BK = 64, HALF = 128, HTB = HALF * BK * 2;
__device__ __forceinline__ int lds_byte(int r, int c) { const int st = (r >> 4) * 2 + (c >> 5), rr = r & 15, cc = c & 31, ob = rr * 64 + cc * 2; return st * 1024 + (ob ^ (((ob >> 9) & 1) << 5)); }
__device__ __forceinline__ void stage_rc(int b, int& R, int& C) { const int st = b / 1024, sb = b % 1024, swz = sb ^ (((sb >> 9) & 1) << 5); R = (st >> 1) * 16 + swz / 64; C = (st & 1) * 32 + (swz % 64) / 2; }
__device__ __forceinline__ int perm32(int rho) { const int n = rho >> 4, i = rho & 15; return 8 * (i >> 2) + 4 * n + (i & 3); }

struct Unit { int pm, pn; const char* a; const char* b; };

template <class Epi, class Map>
__device__ __forceinline__ void gemm_phase(LAS unsigned char* lds, const int nM, const int nN, const int lda2, const int ldb2, const int K, const Map& map, const Epi& E, const int c, const int G, const int w0, const int astr = 0) {
    const int tid = fresh_tid(w0), wid = __builtin_amdgcn_readfirstlane(tid >> 6), lane = tid & 63, wr = wid >> 2, wc = wid & 3, fr = lane & 15, fq = lane >> 4;
    const int nt = K / BK, nwg = nM * nN;
    auto next = [&](int i, Unit& u) -> bool {
        const long L = (long)i * G + c; if (L >= nwg) return false;
        int wgid = (int)L; { const int q = nwg / 8, r = nwg % 8, xcd = wgid % 8, off = wgid / 8; wgid = (xcd < r ? xcd * (q + 1) : r * (q + 1) + (xcd - r) * q) + off; }
        const int nig = 8 * nN, gid = wgid / nig, fm = gid * 8, gsz = (nM - fm) < 8 ? (nM - fm) : 8;
        u.pm = fm + ((wgid % nig) % gsz); u.pn = (wgid % nig) / gsz; map(u); return true;
    };
    unsigned voffA[2], voffB[2];
#pragma unroll
    for (int i = 0; i < 2; ++i) { int R, C; stage_rc(tid * 16 + i * 8192, R, C); const int Rb = (R & ~31) + perm32(R & 31);
        voffA[i] = astr ? (unsigned)((C >> 4) * lda2 + R * 32 + (C & 15) * 2) : (unsigned)(R * lda2 + C * 2); voffB[i] = (unsigned)(Rb * ldb2 + C * 2); }
    const size_t kstep = (size_t)(BK * 2);
    const size_t hstepA = astr ? (size_t)HALF * 32 : (size_t)HALF * lda2, hstepB = (size_t)HALF * ldb2;
    const size_t kstepA = astr ? (size_t)4 * lda2 : kstep;
    const unsigned ldsw = (unsigned)wid * 1024u;
    const int aoff = lds_byte(wr * 64 + fr, fq * 8), boff = lds_byte(wc * 32 + fr, fq * 8);
#define PG8_SA(b, h) (((b) * 2 + (h)) * HTB)
#define PG8_SB(b, h) ((4 + (b) * 2 + (h)) * HTB)
#define PG8_STAGE(bufoff, gbase, voff) do { _Pragma("unroll") for (int _i = 0; _i < 2; ++_i) \
        __builtin_amdgcn_global_load_lds((const unsigned*)((const char*)(gbase) + (voff)[_i]), (LAS unsigned*)(lds + (bufoff) + ldsw + _i * 8192), 16, 0, 0); } while (0)
#define PG8_LDA(dst, b, h) do { _Pragma("unroll") for (int m = 0; m < 4; ++m) _Pragma("unroll") for (int k = 0; k < 2; ++k) dst[m][k] = *(const LAS bf16x8*)(lds + PG8_SA(b, h) + aoff + m * 2048 + k * 1024); } while (0)
#define PG8_LDB(dst, b, h) do { _Pragma("unroll") for (int n = 0; n < 2; ++n) _Pragma("unroll") for (int k = 0; k < 2; ++k) dst[n][k] = *(const LAS bf16x8*)(lds + PG8_SB(b, h) + boff + n * 2048 + k * 1024); } while (0)
#define PG8_MMA(ai, bj, At, Bt) do { __builtin_amdgcn_s_setprio(1); _Pragma("unroll") for (int m = 0; m < 4; ++m) _Pragma("unroll") for (int n = 0; n < 2; ++n) _Pragma("unroll") for (int k = 0; k < 2; ++k) \
        acc[ai][bj][m][n] = __builtin_amdgcn_mfma_f32_16x16x32_bf16(Bt[n][k], At[m][k], acc[ai][bj][m][n], 0, 0, 0); __builtin_amdgcn_s_setprio(0); } while (0)
#define PG8_WAIT_V(n) asm volatile("s_waitcnt vmcnt(" #n ")" ::: "memory")
#define PG8_WAIT_L(n) asm volatile("s_waitcnt lgkmcnt(" #n ")" ::: "memory")
#define PG8_BAR __builtin_amdgcn_s_barrier()
#define PG8_SCHED __builtin_amdgcn_sched_barrier(0)
    Unit cur, nxt; int ui = 0;
    if (!next(0, cur)) return;
    f32x4 acc[2][2][4][2];
#pragma unroll
    for (int a = 0; a < 2; ++a)
#pragma unroll
        for (int b = 0; b < 2; ++b)
#pragma unroll
            for (int m = 0; m < 4; ++m)
#pragma unroll
                for (int n = 0; n < 2; ++n) acc[a][b][m][n] = (f32x4){0.f, 0.f, 0.f, 0.f};
    bf16x8 At[4][2], B0[2][2], B1[2][2];
    const char* cA = cur.a; const char* cB = cur.b;
    PG8_STAGE(PG8_SB(0, 0), cB, voffB); PG8_STAGE(PG8_SA(0, 0), cA, voffA); PG8_STAGE(PG8_SB(0, 1), cB + hstepB, voffB); PG8_STAGE(PG8_SA(0, 1), cA + hstepA, voffA);
    if (wr == 1) PG8_BAR;
    PG8_WAIT_V(4); PG8_BAR;
    PG8_STAGE(PG8_SB(1, 0), cB + kstep, voffB); PG8_STAGE(PG8_SA(1, 0), cA + kstepA, voffA); PG8_STAGE(PG8_SB(1, 1), cB + hstepB + kstep, voffB);
    PG8_WAIT_V(6); PG8_BAR;
    for (;;) {
        const bool has_next = next(ui + 1, nxt);
        const char* nA = has_next ? nxt.a : cA; const char* nB = has_next ? nxt.b : cB;
        for (int t = 0; t < nt; t += 2) {
            const bool last = (t == nt - 2);
            const char* a1 = cA + (size_t)(t + 1) * kstepA;
            const char* a2 = last ? nA : cA + (size_t)(t + 2) * kstepA; const char* b2 = last ? nB : cB + (size_t)(t + 2) * kstep;
            const char* a3 = a2 + kstepA; const char* b3 = b2 + kstep;
            PG8_LDB(B0, 0, 0); PG8_SCHED; PG8_LDA(At, 0, 0); PG8_STAGE(PG8_SA(1, 1), a1 + hstepA, voffA);
            PG8_WAIT_L(8); PG8_BAR; PG8_WAIT_L(0); PG8_MMA(0, 0, At, B0); PG8_BAR; PG8_SCHED;
            PG8_LDB(B1, 0, 1); PG8_STAGE(PG8_SB(0, 0), b2, voffB);
            PG8_BAR; PG8_WAIT_L(0); PG8_MMA(0, 1, At, B1); PG8_BAR;
            PG8_LDA(At, 0, 1); PG8_STAGE(PG8_SA(0, 0), a2, voffA);
            PG8_BAR; PG8_WAIT_L(0); PG8_MMA(1, 0, At, B0); PG8_BAR; PG8_SCHED;
            PG8_STAGE(PG8_SB(0, 1), b2 + hstepB, voffB);
            PG8_WAIT_V(6); PG8_BAR; PG8_MMA(1, 1, At, B1); PG8_BAR;
            PG8_LDB(B0, 1, 0); PG8_SCHED; PG8_LDA(At, 1, 0); PG8_STAGE(PG8_SA(0, 1), a2 + hstepA, voffA);
            PG8_WAIT_L(8); PG8_BAR; PG8_WAIT_L(0); PG8_MMA(0, 0, At, B0); PG8_BAR; PG8_SCHED;
            PG8_LDB(B1, 1, 1); PG8_STAGE(PG8_SB(1, 0), b3, voffB);
            PG8_BAR; PG8_WAIT_L(0); PG8_MMA(0, 1, At, B1); PG8_BAR;
            PG8_LDA(At, 1, 1); PG8_STAGE(PG8_SA(1, 0), a3, voffA);
            PG8_BAR; PG8_WAIT_L(0); PG8_MMA(1, 0, At, B0); PG8_BAR; PG8_SCHED;
            PG8_STAGE(PG8_SB(1, 1), b3 + hstepB, voffB);
            PG8_WAIT_V(6); PG8_BAR; PG8_MMA(1, 1, At, B1); PG8_BAR;
        }
        { int frl = fr, fql = fq; asm volatile("" : "+v"(frl), "+v"(fql)); E(acc, cur, wr, wc, frl, fql); }
        if (!has_next) break;
#pragma unroll
        for (int a = 0; a < 2; ++a)
#pragma unroll
            for (int b = 0; b < 2; ++b)
#pragma unroll
                for (int m = 0; m < 4; ++m)
#pragma unroll
                    for (int n = 0; n < 2; ++n) acc[a][b][m][n] = (f32x4){0.f, 0.f, 0.f, 0.f};
        cur = nxt; cA = nA; cB = nB; ++ui;
    }
    PG8_WAIT_V(0);
    if (wr == 0) PG8_BAR;
    PG8_BAR;
#undef PG8_SA
#undef PG8_SB
#undef PG8_STAGE
#undef PG8_LDA
#undef PG8_LDB
#undef PG8_MMA
#undef PG8_WAIT_V
#undef PG8_WAIT_L
#undef PG8_BAR
#undef PG8_SCHED
}

__device__ __forceinline__ bool row_fence() { asm volatile("" ::: "memory"); return true; }
#define EPI_ARGS const f32x4 (&acc)[2][2][4][2], const Unit& u, int wr, int wc, int fr, int fq
#define FOR_AI _Pragma("unroll") for (int ai = 0; ai < 2; ++ai) if (row_fence())
#define FOR_M _Pragma("unroll") for (int m = 0; m < 4; ++m)
#define FOR_AI_M_NF _Pragma("unroll") for (int ai = 0; ai < 2; ++ai) _Pragma("unroll") for (int m = 0; m < 4; ++m)
#define FOR_BJ _Pragma("unroll") for (int bj = 0; bj < 2; ++bj)

struct EpiIn {
    bf16_t* acat; bf16_t* z; bf16_t* gb; bf16_t* gates; const float* rinv; const float* bgate;
    __device__ __forceinline__ void operator()(EPI_ARGS) const {
        const int row0 = u.pm * BM + wr * 64 + fr, colw = wc * 32 + 8 * fq, pn = u.pn;
        float rv[2][4];
        FOR_AI_M_NF { const int rr = row0 + ai * HALF + m * 16; rv[ai][m] = rinv[(size_t)(rr >> 1) * 32 + (rr & 1)]; }
        if (pn < 2) {
            FOR_AI FOR_M { const int row = row0 + ai * HALF + m * 16; const float r = rv[ai][m]; const int cr = row >> 5, j = row & 31;
                FOR_BJ { const int col = pn * 256 + bj * HALF + colw; const int g = col >> 4, p = col & 15;
                    *(u32x4*)(acat + ((size_t)(cr * NG + g) * KCAT + 256 + j * 16 + p)) = pack8(acc[ai][bj][m][0] * r, acc[ai][bj][m][1] * r); } }
        } else if (pn < 6) {
            FOR_AI FOR_M { const int row = row0 + ai * HALF + m * 16; const float r = rv[ai][m]; const float r2 = r * r;
                *(u32x4*)(z + (size_t)row * 512 + (pn - 2) * HALF + colw) = pack8(acc[ai][0][m][0] * acc[ai][1][m][0] * r2, acc[ai][0][m][1] * acc[ai][1][m][1] * r2); }
        } else if (pn < 8) {
            FOR_AI FOR_M { const int row = row0 + ai * HALF + m * 16; const float r = rv[ai][m];
                FOR_BJ *(u32x4*)(gb + (size_t)row * 512 + (pn - 6) * 256 + bj * HALF + colw) = pack8(acc[ai][bj][m][0] * r, acc[ai][bj][m][1] * r); }
        } else {
            f32x4 bv[2][2];
            FOR_BJ { const float* bp = bgate + (pn - 8) * 256 + bj * HALF + colw; bv[bj][0] = *(const f32x4*)bp; bv[bj][1] = *(const f32x4*)(bp + 4); }
            FOR_AI FOR_M { const int row = row0 + ai * HALF + m * 16; const float r = rv[ai][m];
                FOR_BJ *(u32x4*)(gates + (size_t)row * 2048 + (pn - 8) * 256 + bj * HALF + colw) = pack8(sigmoid4(acc[ai][bj][m][0] * r + bv[bj][0]), sigmoid4(acc[ai][bj][m][1] * r + bv[bj][1])); }
        }
    }
};
struct EpiKV {
    bf16_t* kk; bf16_t* vt; const float* rinv;
    __device__ __forceinline__ void operator()(EPI_ARGS) const {
        const int row0 = u.pm * BM + wr * 64 + fr, colw = wc * 32 + 8 * fq, pn = u.pn;
        float rv[2][4];
        FOR_AI_M_NF { const int rr = row0 + ai * HALF + m * 16; rv[ai][m] = rinv[(size_t)(rr >> 1) * 32 + (rr & 1)]; }
        if (pn < 4) {
            FOR_AI FOR_M { const int row = row0 + ai * HALF + m * 16; const float r = rv[ai][m];
                FOR_BJ *(u32x4*)(kk + (size_t)row * 1024 + pn * 256 + bj * HALF + colw) = pack8(acc[ai][bj][m][0] * r, acc[ai][bj][m][1] * r); }
        } else {
            FOR_AI FOR_M { const int row = row0 + ai * HALF + m * 16; const float r = rv[ai][m];
                FOR_BJ *(u32x4*)(vt + (size_t)row * 1024 + (pn - 4) * 256 + bj * HALF + colw) = pack8(acc[ai][bj][m][0] * r, acc[ai][bj][m][1] * r); }
        }
    }
};
struct EpiState {
    float* S;
    __device__ __forceinline__ void operator()(EPI_ARGS) const {
        const int row0 = u.pm * BM + wr * 64 + fr, colw = wc * 32 + 8 * fq, g = u.pn;
        FOR_AI FOR_M { const int row = row0 + ai * HALF + m * 16;
            FOR_BJ { float* p = S + ((size_t)row * NG + g) * 256 + bj * HALF + colw; *(f32x4*)p = acc[ai][bj][m][0]; *(f32x4*)(p + 4) = acc[ai][bj][m][1]; } }
    }
};
struct EpiY {
    bf16_t* yb;
    __device__ __forceinline__ void operator()(EPI_ARGS) const {
        const int row0 = u.pm * BM + wr * 64 + fr, colw = wc * 32 + 8 * fq, g = u.pn >> 1, pn2 = u.pn & 1;
        FOR_AI FOR_M { const int row = row0 + ai * HALF + m * 16;
            FOR_BJ { const int n = pn2 * 256 + bj * HALF + colw; const int j = n >> 4, p = n & 15;
                *(u32x4*)(yb + ((size_t)g * M + (size_t)row * LC + j) * 16 + p) = pack8(gelu4(acc[ai][bj][m][0]), gelu4(acc[ai][bj][m][1])); } }
    }
};
struct EpiConv {
    bf16_t* part; const bf16_t* gates;
    __device__ __forceinline__ void operator()(EPI_ARGS) const {
        const int row0 = u.pm * BM + wr * 64 + fr, colw = wc * 32 + 8 * fq;
        FOR_AI { u32x4 gw[4][2];
            FOR_M FOR_BJ gw[m][bj] = *(const u32x4*)(gates + (size_t)(row0 + ai * HALF + m * 16) * 2048 + 1024 + u.pn * 256 + bj * HALF + colw);
            FOR_M { const int row = row0 + ai * HALF + m * 16;
                FOR_BJ { const int col = u.pn * 256 + bj * HALF + colw; f32x4 g0, g1; unpack8(gw[m][bj], g0, g1);
                    *(u32x4*)(part + (size_t)row * 1024 + col) = pack8(acc[ai][bj][m][0] * g0, acc[ai][bj][m][1] * g1); } } }
    }
};
struct EpiGlu {
    const bf16_t* part; const bf16_t* gates; bf16_t* merged;
    __device__ __forceinline__ void operator()(EPI_ARGS) const {
        const int row0 = u.pm * BM + wr * 64 + fr, colw = wc * 32 + 8 * fq, col = u.pn * HALF + colw;
        FOR_AI { u32x4 gw[4], pw[4];
            FOR_M { const int row = row0 + ai * HALF + m * 16; gw[m] = *(const u32x4*)(gates + (size_t)row * 2048 + col); pw[m] = *(const u32x4*)(part + (size_t)row * 1024 + col); }
            FOR_M { const int row = row0 + ai * HALF + m * 16; f32x4 g0, g1, p0, p1; unpack8(gw[m], g0, g1); unpack8(pw[m], p0, p1);
                *(u32x4*)(merged + (size_t)row * 1024 + col) = pack8(g0 * acc[ai][0][m][0] * sigmoid4(acc[ai][1][m][0]) + p0, g1 * acc[ai][0][m][1] * sigmoid4(acc[ai][1][m][1]) + p1); } }
    }
};
__device__ __forceinline__ void ssq_exchange(const float (&sv)[2][4], LAS float* xch, float* ssq, const Unit& u, int wr, int wc, int fr, int fq) {
    const int rloc0 = wr * 64 + fr;
    if (fq == 0) { FOR_AI_M_NF xch[(rloc0 + ai * HALF + m * 16) * 4 + wc] = sv[ai][m]; }
    asm volatile("s_waitcnt lgkmcnt(0)" ::: "memory"); __builtin_amdgcn_s_barrier(); asm volatile("" ::: "memory");
    if (wc == 0 && fq == 0) { FOR_AI_M_NF { const int rl = rloc0 + ai * HALF + m * 16; const f32x4 w = *(const LAS f32x4*)(xch + rl * 4);
        ssq[(size_t)u.pn * M + (u.pm * BM + rl)] = (w[0] + w[1]) + (w[2] + w[3]); } }
}
__device__ __forceinline__ float rinv_from4(const f32x4 s) { return rsqrtf(((s[0] + s[1]) + (s[2] + s[3])) * (1.0f / 1024.0f) + EPS); }
struct EpiRes {
    const bf16_t* res; bf16_t* hb; float* ssq; LAS float* xch;
    __device__ __forceinline__ void operator()(EPI_ARGS) const {
        const int row0 = u.pm * BM + wr * 64 + fr, colw = wc * 32 + 8 * fq;
        float sv[2][4];
        FOR_AI { u32x4 rw[4][2];
            FOR_M FOR_BJ rw[m][bj] = *(const u32x4*)(res + (size_t)(row0 + ai * HALF + m * 16) * 1024 + u.pn * 256 + bj * HALF + colw);
            FOR_M { const int row = row0 + ai * HALF + m * 16; float s = 0.f;
                FOR_BJ { const int col = u.pn * 256 + bj * HALF + colw; f32x4 r0, r1; unpack8(rw[m][bj], r0, r1);
                    const f32x4 v0 = r0 + acc[ai][bj][m][0], v1 = r1 + acc[ai][bj][m][1];
                    s += (v0[0] * v0[0] + v0[1] * v0[1]) + (v0[2] * v0[2] + v0[3] * v0[3]) + (v1[0] * v1[0] + v1[1] * v1[1]) + (v1[2] * v1[2] + v1[3] * v1[3]);
                    *(u32x4*)(hb + (size_t)row * 1024 + col) = pack8(v0, v1); }
                s += __shfl_xor(s, 16); s += __shfl_xor(s, 32); sv[ai][m] = s; } }
        ssq_exchange(sv, xch, ssq, u, wr, wc, fr, fq);
    }
};
struct EpiQ {
    bf16_t* q; const float* ssq;
    __device__ __forceinline__ void operator()(EPI_ARGS) const {
        const int row0 = u.pm * BM + wr * 64 + fr, colw = wc * 32 + 8 * fq;
        f32x4 s4[2][4];
        FOR_AI_M_NF { const float* sp = ssq + (row0 + ai * HALF + m * 16); s4[ai][m] = (f32x4){sp[0], sp[M], sp[2 * M], sp[3 * M]}; }
        FOR_AI FOR_M { const int row = row0 + ai * HALF + m * 16; const float r = rinv_from4(s4[ai][m]);
            FOR_BJ *(u32x4*)(q + (size_t)row * 1024 + u.pn * 256 + bj * HALF + colw) = pack8(acc[ai][bj][m][0] * r, acc[ai][bj][m][1] * r); }
    }
};
struct EpiSoftmax {
    bf16_t* P; float* lpart; LAS float* xch;
    __device__ __forceinline__ void operator()(EPI_ARGS) const {
        const int rloc0 = wr * 64 + fr, colw = wc * 32 + 8 * fq;
        FOR_AI_M_NF { float v = -3.0e38f;
            FOR_BJ { const f32x4 a = acc[ai][bj][m][0], b = acc[ai][bj][m][1];
                v = fmaxf(v, fmaxf(fmaxf(fmaxf(a[0], a[1]), fmaxf(a[2], a[3])), fmaxf(fmaxf(b[0], b[1]), fmaxf(b[2], b[3])))); }
            v = fmaxf(v, __shfl_xor(v, 16)); v = fmaxf(v, __shfl_xor(v, 32));
            if (fq == 0) xch[(rloc0 + ai * HALF + m * 16) * 4 + wc] = v; }
        asm volatile("s_waitcnt lgkmcnt(0)" ::: "memory"); __builtin_amdgcn_s_barrier(); asm volatile("" ::: "memory");
        FOR_AI FOR_M { const int rl = rloc0 + ai * HALF + m * 16; const f32x4 w = *(const LAS f32x4*)(xch + rl * 4);
            const float mxx = fmaxf(fmaxf(w[0], w[1]), fmaxf(w[2], w[3])); const int row = u.pm * BM + rl; float s = 0.f;
            FOR_BJ { f32x4 a = acc[ai][bj][m][0], b = acc[ai][bj][m][1];
#pragma unroll
                for (int e = 0; e < 4; ++e) { a[e] = __expf(a[e] - mxx); b[e] = __expf(b[e] - mxx); }
                s += (a[0] + a[1]) + (a[2] + a[3]) + (b[0] + b[1]) + (b[2] + b[3]);
                *(u32x4*)(P + (size_t)row * 1024 + u.pn * 256 + bj * HALF + colw) = pack8(a, b); }
            s += __shfl_xor(s, 16); s += __shfl_xor(s, 32);
            if (fq == 0) lpart[(size_t)row * 16 + u.pn * 4 + wc] = s; }
    }
};
struct EpiPlain {
    bf16_t* out;
    __device__ __forceinline__ void operator()(EPI_ARGS) const {
        const int row0 = u.pm * BM + wr * 64 + fr, colw = wc * 32 + 8 * fq;
        FOR_AI FOR_M { const int row = row0 + ai * HALF + m * 16;
            FOR_BJ *(u32x4*)(out + (size_t)row * 1024 + u.pn * 256 + bj * HALF + colw) = pack8(acc[ai][bj][m][0], acc[ai][bj][m][1]); }
    }
};
struct EpiVW {
    bf16_t* out;
    __device__ __forceinline__ void operator()(EPI_ARGS) const {
        const int rloc0 = wr * 64 + fr, colw = wc * 32 + 8 * fq, b = u.pm >> 2, h = u.pm & 3;
        FOR_AI FOR_M { const int n = u.pn * BM + rloc0 + ai * HALF + m * 16;
            FOR_BJ *(u32x4*)(out + ((size_t)b * 1024 + n) * 1024 + h * 256 + bj * HALF + colw) = pack8(acc[ai][bj][m][0], acc[ai][bj][m][1]); }
    }
};
struct EpiSoftmaxR {
    bf16_t* P; LAS float* xch; const float* ssq;
    __device__ __forceinline__ void operator()(EPI_ARGS) const {
        f32x4 (&ex)[2][2][4][2] = const_cast<f32x4 (&)[2][2][4][2]>(acc);
        const int rloc0 = wr * 64 + fr, colw = wc * 32 + 8 * fq;
        float rv[2][4];
        { f32x4 s4[2][4];
          FOR_AI_M_NF { const float* sp = ssq + (u.pm * BM + rloc0 + ai * HALF + m * 16); s4[ai][m] = (f32x4){sp[0], sp[M], sp[2 * M], sp[3 * M]}; }
          FOR_AI_M_NF rv[ai][m] = rinv_from4(s4[ai][m]); }
        FOR_AI FOR_M { const float r = rv[ai][m]; float v = -3.0e38f;
            FOR_BJ { const f32x4 a = ex[ai][bj][m][0], b = ex[ai][bj][m][1];
                v = fmaxf(v, fmaxf(fmaxf(fmaxf(a[0], a[1]), fmaxf(a[2], a[3])), fmaxf(fmaxf(b[0], b[1]), fmaxf(b[2], b[3])))); }
            v = fmaxf(v, __shfl_xor(v, 16)); v = fmaxf(v, __shfl_xor(v, 32));
            const float mw = v * r; float s = 0.f;
            FOR_BJ { f32x4 a = ex[ai][bj][m][0], b = ex[ai][bj][m][1];
#pragma unroll
                for (int e = 0; e < 4; ++e) { a[e] = __expf(a[e] * r - mw); b[e] = __expf(b[e] * r - mw); }
                s += (a[0] + a[1]) + (a[2] + a[3]) + (b[0] + b[1]) + (b[2] + b[3]);
                ex[ai][bj][m][0] = a; ex[ai][bj][m][1] = b; }
            s += __shfl_xor(s, 16); s += __shfl_xor(s, 32);
            if (fq == 0) { const int rl = rloc0 + ai * HALF + m * 16; xch[rl * 8 + wc * 2] = mw; xch[rl * 8 + wc * 2 + 1] = s; } }
        asm volatile("s_waitcnt lgkmcnt(0)" ::: "memory"); __builtin_amdgcn_s_barrier(); asm volatile("" ::: "memory");
        FOR_AI FOR_M { const int rl = rloc0 + ai * HALF + m * 16;
            const f32x4 w0v = *(const LAS f32x4*)(xch + rl * 8), w1v = *(const LAS f32x4*)(xch + rl * 8 + 4);
            const float mx = fmaxf(fmaxf(w0v[0], w0v[2]), fmaxf(w1v[0], w1v[2]));
            const float l = (w0v[1] * __expf(w0v[0] - mx) + w0v[3] * __expf(w0v[2] - mx)) + (w1v[1] * __expf(w1v[0] - mx) + w1v[3] * __expf(w1v[2] - mx));
            const float mown = wc == 0 ? w0v[0] : (wc == 1 ? w0v[2] : (wc == 2 ? w1v[0] : w1v[2]));
            const float c = __expf(mown - mx) * __builtin_amdgcn_rcpf(l); const int row = u.pm * BM + rl;
            FOR_BJ *(u32x4*)(P + (size_t)row * 1024 + u.pn * 256 + bj * HALF + colw) = pack8(ex[ai][bj][m][0] * c, ex[ai][bj][m][1] * c); }
    }
};
struct EpiPV {
    bf16_t* o; const float* lpart;
    __device__ __forceinline__ void operator()(EPI_ARGS) const {
        const int row0 = u.pm * BM + wr * 64 + fr, colw = wc * 32 + 8 * fq;
        f32x4 l4[2][4];
        FOR_AI_M_NF l4[ai][m] = *(const f32x4*)(lpart + (size_t)(row0 + ai * HALF + m * 16) * 16 + u.pn * 4);
        FOR_AI FOR_M { const int row = row0 + ai * HALF + m * 16; const f32x4 l = l4[ai][m];
            const float r = __builtin_amdgcn_rcpf((l[0] + l[1]) + (l[2] + l[3]));
            FOR_BJ *(u32x4*)(o + (size_t)row * 1024 + u.pn * 256 + bj * HALF + colw) = pack8(acc[ai][bj][m][0] * r, acc[ai][bj][m][1] * r); }
    }
};
struct EpiGU {
    bf16_t* act; const float* ssq;
    __device__ __forceinline__ void operator()(EPI_ARGS) const {
        const int row0 = u.pm * BM + wr * 64 + fr, colw = wc * 32 + 8 * fq;
        f32x4 s4[2][4];
        FOR_AI_M_NF { const float* sp = ssq + (row0 + ai * HALF + m * 16); s4[ai][m] = (f32x4){sp[0], sp[M], sp[2 * M], sp[3 * M]}; }
        FOR_AI FOR_M { const int row = row0 + ai * HALF + m * 16; const float r = rinv_from4(s4[ai][m]);
            const f32x4 g0 = acc[ai][0][m][0] * r, g1 = acc[ai][0][m][1] * r, u0 = acc[ai][1][m][0] * r, u1 = acc[ai][1][m][1] * r;
            *(u32x4*)(act + (size_t)row * DFF + u.pn * HALF + colw) = pack8(g0 * sigmoid4(g0) * u0, g1 * sigmoid4(g1) * u1); }
    }
};
struct EpiDown {
    const bf16_t* res; bf16_t* hb; float* ssq; LAS float* xch;
    __device__ __forceinline__ void operator()(EPI_ARGS) const {
        const int row0 = u.pm * BM + wr * 64 + fr, colw = wc * 32 + 8 * fq;
        float sv[2][4];
        FOR_AI { u32x4 rw[4][2];
            FOR_M FOR_BJ rw[m][bj] = *(const u32x4*)(res + (size_t)(row0 + ai * HALF + m * 16) * 1024 + u.pn * 256 + bj * HALF + colw);
            FOR_M { const int row = row0 + ai * HALF + m * 16; float s = 0.f;
                FOR_BJ { const int col = u.pn * 256 + bj * HALF + colw; f32x4 r0, r1; unpack8(rw[m][bj], r0, r1);
                    const f32x4 v0 = r0 + acc[ai][bj][m][0], v1 = r1 + acc[ai][bj][m][1];
                    const u32x4 w = pack8(v0, v1); f32x4 q0, q1; unpack8(w, q0, q1);
                    s += (q0[0] * q0[0] + q0[1] * q0[1]) + (q0[2] * q0[2] + q0[3] * q0[3]) + (q1[0] * q1[0] + q1[1] * q1[1]) + (q1[2] * q1[2] + q1[3] * q1[3]);
                    *(u32x4*)(hb + (size_t)row * 1024 + col) = w; }
                s += __shfl_xor(s, 16); s += __shfl_xor(s, 32); sv[ai][m] = s; } }
        ssq_exchange(sv, xch, ssq, u, wr, wc, fr, fq);
    }
};

struct MapPlain { const char* A; const char* B; size_t ta, tb; __device__ __forceinline__ void operator()(Unit& u) const { u.a = A + (size_t)u.pm * ta; u.b = B + (size_t)u.pn * tb; } };
struct MapState { const char* acat; const char* bt; __device__ __forceinline__ void operator()(Unit& u) const {
        u.a = acat + ((size_t)u.pm * 256 * NG * KCAT + (size_t)u.pn * KCAT + 256) * 2; u.b = bt + (size_t)u.pn * 256 * 512 * 2; } };
struct MapY { const char* acat; const char* bt; __device__ __forceinline__ void operator()(Unit& u) const {
        const int g = u.pn >> 1; u.a = acat + ((size_t)u.pm * 256 * NG * KCAT + (size_t)g * KCAT) * 2; u.b = bt + ((size_t)g * 512 + (u.pn & 1) * 256) * KCAT * 2; } };
struct MapQK { const char* kk; const char* wqn; __device__ __forceinline__ void operator()(Unit& u) const {
        const int b = u.pm >> 2, h = u.pm & 3; u.a = kk + ((size_t)b * 256 * 1024 + h * 256) * 2; u.b = wqn + ((size_t)u.pn * 256 * 1024 + h * 256) * 2; } };
struct MapSQ { const char* h1; const char* btqk; __device__ __forceinline__ void operator()(Unit& u) const {
        u.a = h1 + (size_t)u.pm * 256 * 1024 * 2; u.b = btqk + (size_t)(batch_of_tile(u.pm) * 4 + u.pn) * 256 * 1024 * 2; } };
struct MapVW { const char* wxo; const char* vn; __device__ __forceinline__ void operator()(Unit& u) const {
        const int b = u.pm >> 2, h = u.pm & 3; u.a = wxo + ((size_t)u.pn * 256 * 1024 + h * 256) * 2; u.b = vn + ((size_t)b * 256 * 1024 + h * 256) * 2; } };
struct MapPVW { const char* P; const char* btvw; __device__ __forceinline__ void operator()(Unit& u) const {
        u.a = P + (size_t)u.pm * 256 * 1024 * 2; u.b = btvw + ((size_t)batch_of_tile(u.pm) * 1024 + u.pn * 256) * 1024 * 2; } };
struct MapS { const char* q; const char* kk; __device__ __forceinline__ void operator()(Unit& u) const {
        u.a = q + ((size_t)u.pm * 256 * 1024 + u.pn * 256) * 2; u.b = kk + ((size_t)batch_of_tile(u.pm) * 256 * 1024 + u.pn * 256) * 2; } };
struct MapPV { const char* P; const char* vt; __device__ __forceinline__ void operator()(Unit& u) const {
        u.a = P + ((size_t)u.pm * 256 * 1024 + u.pn * 256) * 2; u.b = vt + ((size_t)batch_of_tile(u.pm) * 1024 + u.pn * 256) * 256 * 2; } };

__device__ __forceinline__ void cpow_abar(float are, float aim, float dt, int e, float& pr, float& pi) {
    const float mag = expf(are * dt * (float)e);
    double rev = (double)aim * (double)dt * (double)e * 0.15915494309189535; rev -= floor(rev); if (rev > 0.5) rev -= 1.0;
    const float ang = (float)rev * 6.283185307179586f;
    pr = mag * __cosf(ang); pi = mag * __sinf(ang);
}
__device__ __forceinline__ void bbar_coef(float are, float aim, float dt, float& cr, float& ci) {
    const float x = are * dt;
    double rev = (double)aim * (double)dt * 0.15915494309189535; rev -= floor(rev); if (rev > 0.5) rev -= 1.0;
    const float y = (float)rev * 6.283185307179586f;
    const float ex1 = expm1f(x), cy = __cosf(y), sy = __sinf(y), sh = __sinf(0.5f * y);
    const float nr = ex1 * cy - 2.0f * sh * sh, ni = (ex1 + 1.0f) * sy;
    const float den = 1.0f / (are * are + aim * aim);
    cr = (nr * are + ni * aim) * den; ci = (ni * are - nr * aim) * den;
}

__device__ __forceinline__ void transpose_item(const float* W, int ldn, int K, bf16_t* WT, int srccol0, int dstrow0, int k0, const float* gk, float s, LAS float* scr, int lane) {
#pragma unroll 8
    for (int i = 0; i < 32; ++i) { const int kk = 2 * i + (lane >> 5); const float g = gk ? gk[k0 + kk] * s : s;
        scr[kk * 33 + (lane & 31)] = W[(size_t)(k0 + kk) * ldn + srccol0 + (lane & 31)] * g; }
    asm volatile("s_waitcnt lgkmcnt(0)" ::: "memory");
    const int c = lane & 7;
#pragma unroll
    for (int j = 0; j < 4; ++j) { const int n = (lane >> 3) + 8 * j; const LAS float* sp = scr + (8 * c) * 33 + n;
        u32x4 o; o.x = cvt_pk_bf16(sp[0 * 33], sp[1 * 33]); o.y = cvt_pk_bf16(sp[2 * 33], sp[3 * 33]); o.z = cvt_pk_bf16(sp[4 * 33], sp[5 * 33]); o.w = cvt_pk_bf16(sp[6 * 33], sp[7 * 33]);
        *(u32x4*)(WT + (size_t)(dstrow0 + n) * K + k0 + 8 * c) = o; }
    asm volatile("s_waitcnt lgkmcnt(0)" ::: "memory");
}

__device__ __forceinline__ void rows2_to_bf16(const float* xrow0, const float* xrow1, bf16_t* orow0, bf16_t* orow1, float* rinv0, float* rinv1, int lane) {
    const f32x4* xa = (const f32x4*)xrow0 + lane; const f32x4* xb = (const f32x4*)xrow1 + lane;
    f32x4 va[4], vb[4]; float sa = 0.f, sb = 0.f;
#pragma unroll
    for (int j = 0; j < 4; ++j) { va[j] = xa[64 * j]; vb[j] = xb[64 * j]; }
#pragma unroll
    for (int j = 0; j < 4; ++j) { sa += (va[j][0] * va[j][0] + va[j][1] * va[j][1]) + (va[j][2] * va[j][2] + va[j][3] * va[j][3]);
                                  sb += (vb[j][0] * vb[j][0] + vb[j][1] * vb[j][1]) + (vb[j][2] * vb[j][2] + vb[j][3] * vb[j][3]); }
    sa = wave_sum(sa); sb = wave_sum(sb);
    u32x2* oa = (u32x2*)orow0 + lane; u32x2* ob = (u32x2*)orow1 + lane;
#pragma unroll
    for (int j = 0; j < 4; ++j) { u32x2 w; w.x = cvt_pk_bf16(va[j][0], va[j][1]); w.y = cvt_pk_bf16(va[j][2], va[j][3]); oa[64 * j] = w;
                                  u32x2 y; y.x = cvt_pk_bf16(vb[j][0], vb[j][1]); y.y = cvt_pk_bf16(vb[j][2], vb[j][3]); ob[64 * j] = y; }
    if (lane == 0) { *rinv0 = rsqrtf(sa * (1.0f / 1024.0f) + EPS); *rinv1 = rsqrtf(sb * (1.0f / 1024.0f) + EPS); }
}

__device__ __forceinline__ void phase0(const Params& p, LAS unsigned char* lds, const int w0) {
    unsigned char* ws = p.ws;
    const int tid = fresh_tid(w0), wave = tid >> 6, lane = tid & 63, G = gridDim.x;
    const int gw = blockIdx.x * 8 + wave, NGW = G * 8;
    LAS float* scr = (LAS float*)(lds + wave * 16384);
    constexpr int I0 = 16 * 128, I1 = 8 * 64, I2 = 8 * 32, I3 = 16 * 32, I4 = I3, I5 = 16 * 64, I6 = I3, I7 = 16 * 176, I8 = 44 * 32;
    constexpr int NIT = I0 + I1 + I2 + I3 + I4 + I5 + I6 + I7 + I8;
    for (int it = gw; it < NIT; it += NGW) {
        int r = it;
        if (r < I0) { const int kb = r / 128, nb = r % 128, n0 = nb * 32, t = n0 >> 8, w = n0 & 255; int src;
            if (t < 2) src = n0; else if (t < 6) src = (w < 128 ? 512 + (t - 2) * 128 + w : 1536 + (t - 2) * 128 + (w - 128)); else if (t < 8) src = 1024 + (t - 6) * 256 + w; else src = 2048 + (t - 8) * 256 + w;
            transpose_item(p.in[5], 4096, 1024, (bf16_t*)(ws + W_IN), src, n0, kb * 64, p.in[4], 1.0f, scr, lane); continue; } r -= I0;
        if (r < I1) { const int kb = r / 64, nb = r % 64, n0 = nb * 32, t = n0 >> 8, w = n0 & 255;
            transpose_item(w < 128 ? p.in[15] : p.in[16], 1024, 512, (bf16_t*)(ws + W_GLU), t * 128 + (w & 127), n0, kb * 64, nullptr, 1.0f, scr, lane); continue; } r -= I1;
        if (r < I2) { const int kb = r / 32, nb = r % 32; transpose_item(p.in[18], 1024, 512, (bf16_t*)(ws + W_CONV), nb * 32, nb * 32, kb * 64, nullptr, 1.0f, scr, lane); continue; } r -= I2;
        if (r < I3) { const int kb = r / 32, nb = r % 32; transpose_item(p.in[19], 1024, 1024, (bf16_t*)(ws + W_O), nb * 32, nb * 32, kb * 64, nullptr, 1.0f, scr, lane); continue; } r -= I3;
        if (r < I4) { const int kb = r / 32, nb = r % 32; transpose_item(p.in[22], 1024, 1024, (bf16_t*)(ws + W_Q), nb * 32, nb * 32, kb * 64, p.in[20], 0.0625f, scr, lane); continue; } r -= I4;
        if (r < I5) { const int kb = r / 64, nb = r % 64; transpose_item(p.in[23], 2048, 1024, (bf16_t*)(ws + W_KV), nb * 32, nb * 32, kb * 64, p.in[21], 1.0f, scr, lane); continue; } r -= I5;
        if (r < I6) { const int kb = r / 32, nb = r % 32; transpose_item(p.in[24], 1024, 1024, (bf16_t*)(ws + W_XO), nb * 32, nb * 32, kb * 64, nullptr, 1.0f, scr, lane); continue; } r -= I6;
        if (r < I7) { const int kb = r / 176, nb = r % 176, n0 = nb * 32, t = n0 >> 8, w = n0 & 255;
            transpose_item(p.in[26], 5632, 1024, (bf16_t*)(ws + W_GU), w < 128 ? t * 128 + w : DFF + t * 128 + (w - 128), n0, kb * 64, p.in[25], 1.0f, scr, lane); continue; } r -= I7;
        { const int kb = r / 32, nb = r % 32; transpose_item(p.in[27], 1024, DFF, (bf16_t*)(ws + W_DN), nb * 32, nb * 32, kb * 64, nullptr, 1.0f, scr, lane); }
    }
    for (int row = 2 * gw; row < M; row += 2 * NGW) {
        const float* xr = row < MPROMPT ? p.in[0] + (size_t)row * D : p.in[1] + (size_t)(row - MPROMPT) * D;
        rows2_to_bf16(xr, xr + D, (bf16_t*)(ws + SLOT_A) + (size_t)row * D, (bf16_t*)(ws + SLOT_A) + (size_t)(row + 1) * D, (float*)(ws + RINV0P) + (size_t)(row >> 1) * 32, (float*)(ws + RINV0P) + (size_t)(row >> 1) * 32 + 1, lane);
    }
    for (int row = 2 * gw; row < MEMR; row += 2 * NGW) {
        const float* xr = row < 2048 ? p.in[2] + (size_t)row * D : p.in[3] + (size_t)(row - 2048) * D;
        rows2_to_bf16(xr, xr + D, (bf16_t*)(ws + MBUF) + (size_t)row * D, (bf16_t*)(ws + MBUF) + (size_t)(row + 1) * D, (float*)(ws + RINVMP) + (size_t)(row >> 1) * 32, (float*)(ws + RINVMP) + (size_t)(row >> 1) * 32 + 1, lane);
    }
    const float* a_re = p.in[7]; const float* a_im = p.in[8]; const float* log_dt = p.in[9];
    const float* b_re = p.in[10]; const float* b_im = p.in[11]; const float* c_re = p.in[12]; const float* c_im = p.in[13];
    const int gt = blockIdx.x * 512 + tid, NT = G * 512;
    for (int idx = gt; idx < 2 * 32 * 32 * 16; idx += NT) {
        const int pp = idx & 15, m = (idx >> 4) & 31, g = (idx >> 9) & 31, d = idx >> 14, dg = d * 32 + g;
        const float dt = expf(log_dt[dg]);
        float kq[16];
#pragma unroll
        for (int q = 0; q < 16; ++q) kq[q] = 0.f;
        for (int s = 0; s < 64; ++s) {
            const float are = a_re[dg * 64 + s], aim = a_im[dg * 64 + s];
            float pr, pi, cr, ci; cpow_abar(are, aim, dt, m, pr, pi); bbar_coef(are, aim, dt, cr, ci);
            const float tr0 = pr * cr - pi * ci, ti0 = pr * ci + pi * cr;
            const float cre = c_re[(dg * 16 + pp) * 64 + s], cim = c_im[(dg * 16 + pp) * 64 + s];
            const float tr = tr0 * cre - ti0 * cim, ti = tr0 * cim + ti0 * cre;
            const f32x4* br = (const f32x4*)(b_re + (size_t)(dg * 64 + s) * 16); const f32x4* bi = (const f32x4*)(b_im + (size_t)(dg * 64 + s) * 16);
#pragma unroll
            for (int q4 = 0; q4 < 4; ++q4) { const f32x4 r4 = br[q4], i4 = bi[q4];
#pragma unroll
                for (int e = 0; e < 4; ++e) kq[q4 * 4 + e] += tr * r4[e] - ti * i4[e]; }
        }
        f32x4* o = (f32x4*)((float*)(ws + KTAB) + (size_t)idx * 16);
#pragma unroll
        for (int q4 = 0; q4 < 4; ++q4) o[q4] = (f32x4){kq[q4 * 4], kq[q4 * 4 + 1], kq[q4 * 4 + 2], kq[q4 * 4 + 3]};
    }
    for (int idx = gt; idx < 1024 * 128; idx += NT) {
        const int kk = idx >> 7, n8 = (idx & 127) * 8; const float g = p.in[20][kk] * 0.0625f;
        const f32x4 a = *(const f32x4*)(p.in[22] + (size_t)kk * 1024 + n8), b = *(const f32x4*)(p.in[22] + (size_t)kk * 1024 + n8 + 4);
        *(u32x4*)((bf16_t*)(ws + WQN) + (size_t)kk * 1024 + n8) = pack8(a * g, b * g);
    }
}

__device__ __forceinline__ void phase1(const Params& p, LAS unsigned char* lds, const int w0) {
    unsigned char* ws = p.ws; const int tid = fresh_tid(w0), G = gridDim.x;
    { EpiIn E{(bf16_t*)(ws + SLOT_B), (bf16_t*)(ws + SLOT_C), (bf16_t*)(ws + SLOT_C + HALF_SLOT), (bf16_t*)p.out, (const float*)(ws + RINV0P), p.in[6]};
      MapPlain mp{(const char*)(ws + SLOT_A), (const char*)(ws + W_IN), (size_t)256 * 1024 * 2, (size_t)256 * 1024 * 2};
      gemm_phase(lds, M / 256, 16, 2048, 2048, 1024, mp, E, blockIdx.x, G, w0); }
    { EpiKV E{(bf16_t*)(ws + KK), (bf16_t*)(ws + VT), (const float*)(ws + RINVMP)};
      MapPlain mp{(const char*)(ws + MBUF), (const char*)(ws + W_KV), (size_t)256 * 1024 * 2, (size_t)256 * 1024 * 2};
      gemm_phase(lds, MEMR / 256, 8, 2048, 2048, 1024, mp, E, G - 1 - blockIdx.x, G, w0); }
    if ((int)blockIdx.x < G - 96) {
      const int ND = G - 96, gt = blockIdx.x * 512 + tid, NT = ND * 512;
      const float* a_re = p.in[7]; const float* a_im = p.in[8]; const float* log_dt = p.in[9];
      const float* b_re = p.in[10]; const float* b_im = p.in[11]; const float* c_re = p.in[12]; const float* c_im = p.in[13];
    for (int idx = gt; idx < 32 * 256 * 32; idx += NT) {
        const int j = idx & 31, n = (idx >> 5) & 255, g = idx >> 13, d = n >> 7, ri = (n >> 6) & 1, s = n & 63, dg = d * 32 + g;
        const float dt = expf(log_dt[dg]), are = a_re[dg * 64 + s], aim = a_im[dg * 64 + s];
        float pr, pi, cr, ci; cpow_abar(are, aim, dt, d == 0 ? (LC - 1 - j) : j, pr, pi); bbar_coef(are, aim, dt, cr, ci);
        const float tr = pr * cr - pi * ci, ti = pr * ci + pi * cr;
        const f32x4* br = (const f32x4*)(b_re + (size_t)(dg * 64 + s) * 16); const f32x4* bi = (const f32x4*)(b_im + (size_t)(dg * 64 + s) * 16);
        f32x4 v[4];
#pragma unroll
        for (int q4 = 0; q4 < 4; ++q4) { const f32x4 r4 = br[q4], i4 = bi[q4]; v[q4] = ri == 0 ? (r4 * tr - i4 * ti) : (i4 * tr + r4 * ti); }
        u32x4* o = (u32x4*)((bf16_t*)(ws + BT_STATE) + ((size_t)(g * 256 + n) * 512 + j * 16));
        o[0] = pack8(v[0], v[1]); o[1] = pack8(v[2], v[3]);
    }
    for (int idx = gt; idx < 32 * 32 * 2 * 64; idx += NT) {
        const int s = idx & 63, d = (idx >> 6) & 1, j = (idx >> 7) & 31, g = idx >> 12, dg = d * 32 + g;
        const float dt = expf(log_dt[dg]), are = a_re[dg * 64 + s], aim = a_im[dg * 64 + s];
        float pr, pi; cpow_abar(are, aim, dt, d == 0 ? (j + 1) : (LC - j), pr, pi);
        bf16_t* o = (bf16_t*)(ws + BT_Y) + ((size_t)(g * 512 + j * 16) * KCAT + d * 128 + s);
#pragma unroll 4
        for (int pp = 0; pp < 16; ++pp) { const float cre = c_re[(dg * 16 + pp) * 64 + s], cim = c_im[(dg * 16 + pp) * 64 + s];
            const unsigned w = cvt_pk_bf16(cre * pr - cim * pi, -(cre * pi + cim * pr));
            o[(size_t)pp * KCAT] = (bf16_t)(w & 0xffff); o[(size_t)pp * KCAT + 64] = (bf16_t)(w >> 16); }
    }
    { const float* ktab = (const float*)(ws + KTAB); const float* dsk = p.in[14];
      for (int idx = gt; idx < 32 * 32 * 16 * 32; idx += NT) {
        const int i = idx & 31, pp = (idx >> 5) & 15, j = (idx >> 9) & 31, g = idx >> 14;
        f32x4 v[4];
#pragma unroll
        for (int q4 = 0; q4 < 4; ++q4) v[q4] = (f32x4){0.f, 0.f, 0.f, 0.f};
        if (i <= j) { const f32x4* k = (const f32x4*)(ktab + ((size_t)((0 * 32 + g) * 32 + (j - i)) * 256 + pp * 16));
#pragma unroll
            for (int q4 = 0; q4 < 4; ++q4) v[q4] += k[q4]; }
        if (i >= j) { const f32x4* k = (const f32x4*)(ktab + ((size_t)((1 * 32 + g) * 32 + (i - j)) * 256 + pp * 16));
#pragma unroll
            for (int q4 = 0; q4 < 4; ++q4) v[q4] += k[q4]; }
        if (i == j) { const float dv = dsk[g * 16 + pp];
#pragma unroll
            for (int q4 = 0; q4 < 4; ++q4)
#pragma unroll
                for (int e = 0; e < 4; ++e) if (q4 * 4 + e == pp) v[q4][e] += dv; }
        u32x4* o = (u32x4*)((bf16_t*)(ws + BT_Y) + ((size_t)(g * 512 + j * 16 + pp) * KCAT + 256 + i * 16));
        o[0] = pack8(v[0], v[1]); o[1] = pack8(v[2], v[3]);
      } }
    }
}

__device__ __forceinline__ void phase2(const Params& p, LAS unsigned char* lds, const int w0) {
    unsigned char* ws = p.ws; const int tid = fresh_tid(w0), G = gridDim.x;
    { EpiState E{(float*)(ws + SLOT_D)};
      MapState mp{(const char*)(ws + SLOT_B), (const char*)(ws + BT_STATE)};
      gemm_phase(lds, (M / LC) / 256, NG, NG * KCAT * 2, 512 * 2, 512, mp, E, blockIdx.x, G, w0); }
    { EpiPlain E{(bf16_t*)(ws + BT_QK)};
      MapQK mp{(const char*)(ws + KK), (const char*)(ws + WQN)};
      gemm_phase(lds, 48, 4, 2048, 2048, 256, mp, E, G - 1 - blockIdx.x, G, w0); }
    { EpiVW E{(bf16_t*)(ws + BT_VW)};
      MapVW mp{(const char*)(ws + W_XO), (const char*)(ws + VT)};
      gemm_phase(lds, 48, 4, 2048, 2048, 256, mp, E, G - 1 - blockIdx.x, G, w0); }
    { const bf16_t* z = (const bf16_t*)(ws + SLOT_C); const bf16_t* gb = (const bf16_t*)(ws + SLOT_C + HALF_SLOT); bf16_t* cz = (bf16_t*)(ws + SLOT_D + HALF_SLOT);
      const float* cw = p.in[17];
      for (int idx = blockIdx.x * 512 + tid; idx < M * 64; idx += G * 512) {
        const int c8 = (idx & 63) * 8, t = idx >> 6;
        const int pos = t < MPROMPT ? (t & 8191) : ((t - MPROMPT) & 4095), L = t < MPROMPT ? 8192 : 4096;
        f32x4 w0a = *(const f32x4*)(cw + c8), w0b = *(const f32x4*)(cw + c8 + 4), w1a = *(const f32x4*)(cw + 512 + c8), w1b = *(const f32x4*)(cw + 512 + c8 + 4), w2a = *(const f32x4*)(cw + 1024 + c8), w2b = *(const f32x4*)(cw + 1024 + c8 + 4);
        f32x4 z0, z1, a0, a1; unpack8(*(const u32x4*)(z + (size_t)t * 512 + c8), z0, z1);
        a0 = w1a * z0; a1 = w1b * z1;
        if (pos > 0) { unpack8(*(const u32x4*)(z + (size_t)(t - 1) * 512 + c8), z0, z1); a0 += w0a * z0; a1 += w0b * z1; }
        if (pos < L - 1) { unpack8(*(const u32x4*)(z + (size_t)(t + 1) * 512 + c8), z0, z1); a0 += w2a * z0; a1 += w2b * z1; }
        unpack8(*(const u32x4*)(gb + (size_t)t * 512 + c8), z0, z1);
        *(u32x4*)(cz + (size_t)t * 512 + c8) = pack8(a0 * z0, a1 * z1);
      } }
}

__device__ __forceinline__ void phase3(const Params& p, LAS unsigned char* lds, const int w0) {
    unsigned char* ws = p.ws; const int tid = fresh_tid(w0), wave = tid >> 6, lane = tid & 63, G = gridDim.x;
    { const float* S = (const float*)(ws + SLOT_D); bf16_t* acat = (bf16_t*)(ws + SLOT_B);
      const float* a_re = p.in[7]; const float* a_im = p.in[8]; const float* log_dt = p.in[9];
      for (int item = blockIdx.x + G * wave; item < 12 * 32 * 2; item += G * 8) {
        const int d = item & 1, g = (item >> 1) & 31, b = item >> 6, dg = d * 32 + g;
        const int cr0 = b < 8 ? b * 256 : 2048 + (b - 8) * 128, nch = b < 8 ? 256 : 128;
        const float dt = expf(log_dt[dg]);
        float ar, ai; cpow_abar(a_re[dg * 64 + lane], a_im[dg * 64 + lane], dt, LC, ar, ai);
        float hr = 0.f, hi = 0.f;
        const int step = d == 0 ? 1 : -1; int c = d == 0 ? cr0 : cr0 + nch - 1;
        float sr[8], si[8];
#pragma unroll
        for (int e = 0; e < 8; ++e) { const float* sp = S + ((size_t)(c + e * step) * NG + g) * 256 + d * 128 + lane; sr[e] = sp[0]; si[e] = sp[64]; }
        for (int blk = 0; blk < nch; blk += 8) {
            float nr[8], ni[8];
            const bool more = blk + 8 < nch;
#pragma unroll
            for (int e = 0; e < 8; ++e) { const int cc = more ? c + (8 + e) * step : c; const float* sp = S + ((size_t)cc * NG + g) * 256 + d * 128 + lane; nr[e] = sp[0]; ni[e] = sp[64]; }
#pragma unroll
            for (int e = 0; e < 8; ++e) {
                bf16_t* hp = acat + ((size_t)(c + e * step) * NG + g) * KCAT + d * 128 + lane;
                const unsigned w = cvt_pk_bf16(hr, hi); hp[0] = (bf16_t)(w & 0xffff); hp[64] = (bf16_t)(w >> 16);
                const float t = ar * hr - ai * hi + sr[e]; hi = ar * hi + ai * hr + si[e]; hr = t;
            }
#pragma unroll
            for (int e = 0; e < 8; ++e) { sr[e] = nr[e]; si[e] = ni[e]; }
            c += 8 * step;
        }
      } }
    __syncthreads();
    { EpiConv E{(bf16_t*)(ws + SLOT_E), (const bf16_t*)p.out};
      MapPlain mp{(const char*)(ws + SLOT_D + HALF_SLOT), (const char*)(ws + W_CONV), (size_t)256 * 512 * 2, (size_t)256 * 512 * 2};
      gemm_phase(lds, M / 256, 4, 1024, 1024, 512, mp, E, blockIdx.x, G, w0); }
}

__device__ __forceinline__ void phase4(const Params& p, LAS unsigned char* lds, const int w0) {
    unsigned char* ws = p.ws;
    EpiY E{(bf16_t*)(ws + SLOT_C)};
    MapY mp{(const char*)(ws + SLOT_B), (const char*)(ws + BT_Y)};
    gemm_phase(lds, (M / LC) / 256, NG * 2, NG * KCAT * 2, KCAT * 2, KCAT, mp, E, blockIdx.x, gridDim.x, w0);
}
__device__ __forceinline__ void phase5(const Params& p, LAS unsigned char* lds, const int w0) {
    unsigned char* ws = p.ws;
    EpiGlu E{(const bf16_t*)(ws + SLOT_E), (const bf16_t*)p.out, (bf16_t*)(ws + SLOT_D)};
    MapPlain mp{(const char*)(ws + SLOT_C), (const char*)(ws + W_GLU), (size_t)256 * 32, (size_t)256 * 512 * 2};
    gemm_phase(lds, M / 256, 8, M * 32, 1024, 512, mp, E, blockIdx.x, gridDim.x, w0, 1);
}
__device__ __forceinline__ void phase6(const Params& p, LAS unsigned char* lds, const int w0) {
    unsigned char* ws = p.ws;
    EpiRes E{(const bf16_t*)(ws + SLOT_A), (bf16_t*)(ws + SLOT_C), (float*)(ws + SSQ1), (LAS float*)(lds + STAGE_BYTES)};
    MapPlain mp{(const char*)(ws + SLOT_D), (const char*)(ws + W_O), (size_t)256 * 1024 * 2, (size_t)256 * 1024 * 2};
    gemm_phase(lds, M / 256, 4, 2048, 2048, 1024, mp, E, blockIdx.x, gridDim.x, w0);
}
__device__ __forceinline__ void phase7(const Params& p, LAS unsigned char* lds, const int w0) {
    unsigned char* ws = p.ws;
    EpiSoftmaxR E{(bf16_t*)(ws + SLOT_D), (LAS float*)(lds + STAGE_BYTES), (const float*)(ws + SSQ1)};
    MapSQ mp{(const char*)(ws + SLOT_C), (const char*)(ws + BT_QK)};
    gemm_phase(lds, M / 256, 4, 2048, 2048, 1024, mp, E, blockIdx.x, gridDim.x, w0);
}
__device__ __forceinline__ void phase9(const Params& p, LAS unsigned char* lds, const int w0) {
    unsigned char* ws = p.ws;
    EpiRes E{(const bf16_t*)(ws + SLOT_C), (bf16_t*)(ws + SLOT_A), (float*)(ws + SSQ2), (LAS float*)(lds + STAGE_BYTES)};
    MapPVW mp{(const char*)(ws + SLOT_D), (const char*)(ws + BT_VW)};
    gemm_phase(lds, M / 256, 4, 2048, 2048, 1024, mp, E, blockIdx.x, gridDim.x, w0);
}
__device__ __forceinline__ void phase11(const Params& p, LAS unsigned char* lds, const int w0) {
    unsigned char* ws = p.ws;
    EpiGU E{(bf16_t*)(ws + SLOT_B), (const float*)(ws + SSQ2)};
    MapPlain mp{(const char*)(ws + SLOT_A), (const char*)(ws + W_GU), (size_t)256 * 1024 * 2, (size_t)256 * 1024 * 2};
    gemm_phase(lds, M / 256, 22, 2048, 2048, 1024, mp, E, blockIdx.x, gridDim.x, w0);
}
__device__ __forceinline__ void phase12(const Params& p, LAS unsigned char* lds, const int w0) {
    unsigned char* ws = p.ws;
    EpiDown E{(const bf16_t*)(ws + SLOT_A), (bf16_t*)(ws + SLOT_E), (float*)(ws + SSQ3), (LAS float*)(lds + STAGE_BYTES)};
    MapPlain mp{(const char*)(ws + SLOT_B), (const char*)(ws + W_DN), (size_t)256 * DFF * 2, (size_t)256 * DFF * 2};
    gemm_phase(lds, M / 256, 4, DFF * 2, DFF * 2, DFF, mp, E, blockIdx.x, gridDim.x, w0);
}
__device__ __forceinline__ void phase13(const Params& p, const int w0) {
    unsigned char* ws = p.ws; const int tid = fresh_tid(w0), wave = tid >> 6, lane = tid & 63;
    const float* gf = p.in[28]; const float* ssq = (const float*)(ws + SSQ3); const bf16_t* h3 = (const bf16_t*)(ws + SLOT_E);
    f32x4 ga[2], gb2[2];
#pragma unroll
    for (int j = 0; j < 2; ++j) { ga[j] = *(const f32x4*)(gf + j * 512 + lane * 8); gb2[j] = *(const f32x4*)(gf + j * 512 + lane * 8 + 4); }
    for (int row = 2 * (blockIdx.x * 8 + wave); row < M; row += 2 * gridDim.x * 8) {
        u32x4 w0a[2], w1a[2];
#pragma unroll
        for (int j = 0; j < 2; ++j) { w0a[j] = *(const u32x4*)(h3 + (size_t)row * D + j * 512 + lane * 8); w1a[j] = *(const u32x4*)(h3 + (size_t)(row + 1) * D + j * 512 + lane * 8); }
        const float r0 = rinv_from_ssq4(ssq, row), r1 = rinv_from_ssq4(ssq, row + 1);
#pragma unroll
        for (int j = 0; j < 2; ++j) { f32x4 a, b; unpack8(w0a[j], a, b);
            float* o = p.out + (size_t)row * D + j * 512 + lane * 8; *(f32x4*)o = a * r0 * ga[j]; *(f32x4*)(o + 4) = b * r0 * gb2[j];
            unpack8(w1a[j], a, b);
            float* o1 = p.out + (size_t)(row + 1) * D + j * 512 + lane * 8; *(f32x4*)o1 = a * r1 * ga[j]; *(f32x4*)(o1 + 4) = b * r1 * gb2[j]; }
    }
}

template <bool COOP>
__global__ void __launch_bounds__(512, 2) fwd_kernel(Params p) {
    extern __shared__ __attribute__((aligned(16))) unsigned char lds_raw[];
    LAS unsigned char* lds = (LAS unsigned char*)lds_raw;
    const int w0 = __builtin_amdgcn_readfirstlane((int)threadIdx.x >> 6);
    unsigned* const bar = (unsigned*)(p.ws + BARW);
    unsigned* const bctr = bar + HB_CTR;
    volatile LAS unsigned* const basew = (volatile LAS unsigned*)(lds + STAGE_BYTES + 8192);
    if constexpr (COOP) {
        if (w0 == 0 && __builtin_amdgcn_mbcnt_hi(~0u, __builtin_amdgcn_mbcnt_lo(~0u, 0u)) == 0u) {
            const unsigned x = hb_xcc();
            basew[0] = xb_read(bctr); basew[3] = xb_read(&bar[HB_XSUB(x)]); basew[4] = xb_read(&bar[HB_XGEN(x)]); basew[5] = xb_read(&bar[HB_TOP]); basew[6] = xb_read(&bar[HB_TOPGEN]);
            for (unsigned j = 0; j < 16; ++j) basew[8 + j] = xb_read(&bar[HB_XCNT(j)]);
        }
        __syncthreads();
    }
    unsigned seam = 0u;
#define RUN_PHASE(k, call) if (p.ph_lo <= (k) && (k) < p.ph_hi) { call; if constexpr (COOP) { if ((k) + 1 < p.ph_hi) { \
        if ((k) == 0) { cg::this_grid().sync(); if (w0 == 0 && __builtin_amdgcn_mbcnt_hi(~0u, __builtin_amdgcn_mbcnt_lo(~0u, 0u)) == 0u) (void)xb_add(&bar[HB_XCNT(hb_xcc())], 1u); } \
        else if (seam == 0u) { ++seam; ctr_barrier(bctr, basew, 1u, w0); \
            if (w0 == 0 && __builtin_amdgcn_mbcnt_hi(~0u, __builtin_amdgcn_mbcnt_lo(~0u, 0u)) == 0u) { const unsigned x = hb_xcc(); unsigned nx = 0u, nloc = 1u; \
                for (unsigned j = 0; j < 16; ++j) { const unsigned n = xb_read(&bar[HB_XCNT(j)]) - basew[8 + j]; nx += n ? 1u : 0u; if (j == x) nloc = n; } \
                basew[1] = nloc; basew[2] = nx ? nx : 1u; } \
            __syncthreads(); } \
        else { hier_barrier(bar, basew, seam, w0); ++seam; } } } }
    RUN_PHASE(0, phase0(p, lds, w0))
    RUN_PHASE(1, phase1(p, lds, w0))
    RUN_PHASE(2, phase2(p, lds, w0))
    RUN_PHASE(3, phase3(p, lds, w0))
    RUN_PHASE(4, phase4(p, lds, w0))
    RUN_PHASE(5, phase5(p, lds, w0))
    RUN_PHASE(6, phase6(p, lds, w0))
    RUN_PHASE(7, phase7(p, lds, w0))
    RUN_PHASE(9, phase9(p, lds, w0))
    RUN_PHASE(11, phase11(p, lds, w0))
    RUN_PHASE(12, phase12(p, lds, w0))
    RUN_PHASE(13, phase13(p, w0))
#undef RUN_PHASE
}

extern "C" void kernel_launch(void* const* d_in, const int* in_sizes, int n_in, void* d_out, int out_size, void* d_ws, size_t ws_size, hipStream_t stream) {
    static int grid = 0;
    if (grid == 0) {
        if (n_in != 29 || out_size != M * D || ws_size < WS_END) { fprintf(stderr, "kernel_launch: unexpected shapes (n_in %d out %d ws %zu need %zu)\n", n_in, out_size, ws_size, (size_t)WS_END); grid = -1; return; }
        int dev = 0, cus = 0, per_cu = 0;
        (void)hipGetDevice(&dev); (void)hipDeviceGetAttribute(&cus, hipDeviceAttributeMultiprocessorCount, dev);
        (void)hipFuncSetAttribute((const void*)fwd_kernel<N_LAUNCH_MODE == 1>, hipFuncAttributeMaxDynamicSharedMemorySize, LDS_BYTES);
        (void)hipOccupancyMaxActiveBlocksPerMultiprocessor(&per_cu, (const void*)fwd_kernel<N_LAUNCH_MODE == 1>, 512, LDS_BYTES);
        if (per_cu < 1) per_cu = 1;
        grid = cus * 1;
        (void)hipGetLastError();
    }
    if (grid < 0) return;
    Params p{};
    for (int i = 0; i < 29; ++i) p.in[i] = (const float*)d_in[i];
    p.out = (float*)d_out; p.ws = (unsigned char*)d_ws;
#if N_LAUNCH_MODE == 1
    p.ph_lo = 0; p.ph_hi = NPHASE;
    void* args[] = {&p};
    hipError_t e = hipLaunchCooperativeKernel((const void*)fwd_kernel<true>, dim3(grid), dim3(512), args, LDS_BYTES, stream);
    if (e != hipSuccess) fprintf(stderr, "cooperative launch failed: %s (grid %d)\n", hipGetErrorString(e), grid);
#else
    for (int ph = 0; ph < NPHASE; ++ph) {
        p.ph_lo = ph; p.ph_hi = ph + 1;
        hipLaunchKernelGGL(fwd_kernel<false>, dim3(grid), dim3(512), LDS_BYTES, stream, p);
    }
#endif
}
```
